# Optimizing an MI355X kernel written in HIP

```python
import jax, jax.numpy as jnp
from jax import lax
import numpy as np

D_MODEL = 1024
BATCH = 1
SEQ = 16384
DEPTH = 4
DEC_BATCH = 32
DEC_SEQ = 16
PAST_LEN = 1024

CHUNK = 64
N_PREV_CHUNKS = 8
BAND = (N_PREV_CHUNKS + 1) * CHUNK
N_HEADS = 8
HEAD_DIM = 64
ATTN_WIDTH = N_HEADS * HEAD_DIM
ATTN_SCALE = HEAD_DIM ** -0.5
REL_CLIP = 128
POOL_WINDOWS = (2, 4, 8, 16)
N_POOL_GROUPS = len(POOL_WINDOWS)
POOL_GROUP = 64
POOL_WIDTH = N_POOL_GROUPS * POOL_GROUP
POOL_HIST = max(POOL_WINDOWS) - 1
CONV_WIDTH = 256
CONV_K = 3
D_FF = 2816
N_BRANCH = 3
IN_WIDTH = 3 * ATTN_WIDTH + POOL_WIDTH + 3 * CONV_WIDTH + N_BRANCH * D_MODEL
SPLITS = (ATTN_WIDTH, 2 * ATTN_WIDTH, 3 * ATTN_WIDTH,
          3 * ATTN_WIDTH + POOL_WIDTH,
          3 * ATTN_WIDTH + POOL_WIDTH + CONV_WIDTH,
          3 * ATTN_WIDTH + POOL_WIDTH + 2 * CONV_WIDTH,
          3 * ATTN_WIDTH + POOL_WIDTH + 3 * CONV_WIDTH)
EPS = 1e-6
NEG_INF = -1e30

kernel_name = 'hybrid_streaming_encoder_step'


def rmsnorm(x, g):
    xf = x.astype(jnp.float32)
    y = xf * lax.rsqrt(jnp.mean(xf * xf, axis=-1, keepdims=True) + EPS)
    return (y * g.astype(jnp.float32)).astype(x.dtype)


def swiglu(h, w_in, w_out):
    g, u = jnp.split(h @ w_in, 2, axis=-1)
    return (jax.nn.silu(g) * u) @ w_out


def rel_bias_table(rel_bias, rel):
    idx = jnp.clip(rel, -REL_CLIP, REL_CLIP) + REL_CLIP
    return rel_bias[:, idx].astype(jnp.float32)


def band_attention_prompt(q, k, v, rel_bias):
    B, S, H, Dh = q.shape
    nc = S // CHUNK
    pad = N_PREV_CHUNKS * CHUNK
    kp = jnp.pad(k, ((0, 0), (pad, 0), (0, 0), (0, 0))).reshape(B, nc + N_PREV_CHUNKS, CHUNK, H, Dh)
    vp = jnp.pad(v, ((0, 0), (pad, 0), (0, 0), (0, 0))).reshape(B, nc + N_PREV_CHUNKS, CHUNK, H, Dh)
    kb = jnp.concatenate([kp[:, i:i + nc] for i in range(N_PREV_CHUNKS + 1)], axis=2)
    vb = jnp.concatenate([vp[:, i:i + nc] for i in range(N_PREV_CHUNKS + 1)], axis=2)
    qc = q.reshape(B, nc, CHUNK, H, Dh)
    q_off = jnp.arange(CHUNK)
    k_off = jnp.arange(BAND) - pad
    bias = rel_bias_table(rel_bias, k_off[None, :] - q_off[:, None])
    valid = (jnp.arange(nc)[:, None] * CHUNK + k_off[None, :]) >= 0
    s = jnp.einsum('bcqhd,bckhd->bchqk', qc, kb).astype(jnp.float32) * ATTN_SCALE + bias[None, None]
    s = jnp.where(valid[None, :, None, None, :], s, NEG_INF)
    p = jax.nn.softmax(s, axis=-1).astype(v.dtype)
    o = jnp.einsum('bchqk,bckhd->bcqhd', p, vb)
    return o.reshape(B, S, H * Dh)


def band_attention_sample(q, k_new, v_new, k_cache, v_cache, rel_bias):
    Bd, T, H, Dh = q.shape
    R = k_cache.shape[1]
    k = jnp.concatenate([k_cache, k_new], axis=1)
    v = jnp.concatenate([v_cache, v_new], axis=1)
    q_off = jnp.arange(T)
    k_off = jnp.arange(R + T) - R
    bias = rel_bias_table(rel_bias, k_off[None, :] - q_off[:, None])
    s = jnp.einsum('bqhd,bkhd->bhqk', q, k).astype(jnp.float32) * ATTN_SCALE + bias[None]
    p = jax.nn.softmax(s, axis=-1).astype(v.dtype)
    o = jnp.einsum('bhqk,bkhd->bqhd', p, v)
    return o.reshape(Bd, T, H * Dh)


def pool_mixer(u, hist, pos0, pool_w, pool_scale):
    B, L, C = u.shape
    ext = jnp.concatenate([hist, u], axis=1).astype(jnp.float32)
    cs = jnp.pad(jnp.cumsum(ext, axis=1), ((0, 0), (1, 0), (0, 0)))
    upper = cs[:, POOL_HIST + 1:]
    pos = pos0 + jnp.arange(L)
    means = []
    for g, w in enumerate(POOL_WINDOWS):
        lo = POOL_HIST + 1 - w
        sl = slice(g * POOL_GROUP, (g + 1) * POOL_GROUP)
        cnt = jnp.minimum(w, pos + 1).astype(jnp.float32)
        means.append((upper[..., sl] - cs[:, lo:lo + L, sl]) / cnt[None, :, None])
    d = (jnp.concatenate(means, axis=-1) - u.astype(jnp.float32)).astype(u.dtype)
    d = d.reshape(B, L, N_POOL_GROUPS, POOL_GROUP)
    o = jnp.einsum('blgc,gcd->blgd', d, pool_w).reshape(B, L, C)
    return o * pool_scale


def causal_dwconv(u, hist, conv_w, conv_b):
    L = u.shape[1]
    ext = jnp.concatenate([hist, u], axis=1)
    y = conv_b
    for i in range(CONV_K):
        y = y + ext[:, i:i + L] * conv_w[i]
    return y


def trunk_layer(x, attn_cache, pool_hist, conv_hist, pos0, w):
    B, L, _ = x.shape
    x = x + 0.5 * swiglu(rmsnorm(x, w['ffn1_norm']), w['ffn1_w_in'], w['ffn1_w_out'])
    h = rmsnorm(x, w['mix_norm'])
    q, k, v, pu, cu, cb, cc, gl = jnp.split(h @ w['mix_w_in'], SPLITS, axis=-1)
    q = rmsnorm(q.reshape(B, L, N_HEADS, HEAD_DIM), w['q_norm'])
    k = rmsnorm(k.reshape(B, L, N_HEADS, HEAD_DIM), w['k_norm'])
    v = v.reshape(B, L, N_HEADS, HEAD_DIM)
    if attn_cache is None:
        o_attn = band_attention_prompt(q, k, v, w['rel_bias'])
        r_keep = min(N_PREV_CHUNKS * CHUNK, L)
        new_k, new_v = k[:, L - r_keep:], v[:, L - r_keep:]
    else:
        o_attn = band_attention_sample(q, k, v, attn_cache[0], attn_cache[1], w['rel_bias'])
        new_k, new_v = k, v
    o_pool = pool_mixer(pu, pool_hist, pos0, w['pool_w'], w['pool_scale'])
    new_pool = jnp.concatenate([pool_hist, pu], axis=1)[:, -POOL_HIST:]
    c_in = cc * cu
    o_conv = cb * causal_dwconv(c_in, conv_hist, w['conv_w'], w['conv_b'])
    new_conv = jnp.concatenate([conv_hist, c_in], axis=1)[:, -(CONV_K - 1):]
    gates = jax.nn.sigmoid(gl + w['gate_b']).reshape(B, L, N_BRANCH, D_MODEL)
    m = (gates[:, :, 0] * (o_attn @ w['w_branch_attn'])
         + gates[:, :, 1] * (o_pool @ w['w_branch_pool'])
         + gates[:, :, 2] * (o_conv @ w['w_branch_conv']))
    x = x + m @ w['w_out']
    x = x + 0.5 * swiglu(rmsnorm(x, w['ffn2_norm']), w['ffn2_w_in'], w['ffn2_w_out'])
    return x, new_k, new_v, new_pool, new_conv


def setup_inputs(seed: int = 0) -> dict:
    key = jax.random.key(seed)
    ks = jax.random.split(key, 32)
    f32 = jnp.float32

    def nrm(k, shape, scale):
        return jax.random.normal(k, shape, f32) * scale

    R = min(N_PREV_CHUNKS * CHUNK, PAST_LEN)
    return {
        'x_prompt': nrm(ks[0], (BATCH, SEQ, D_MODEL), 1.0),
        'x_sample': nrm(ks[1], (DEC_BATCH, DEC_SEQ, D_MODEL), 1.0),
        'cache_attn_k': nrm(ks[2], (DEPTH, DEC_BATCH, R, N_HEADS, HEAD_DIM), 1.0),
        'cache_attn_v': nrm(ks[3], (DEPTH, DEC_BATCH, R, N_HEADS, HEAD_DIM), 1.0),
        'state_pool': nrm(ks[4], (DEPTH, DEC_BATCH, POOL_HIST, POOL_WIDTH), 1.0),
        'state_conv': nrm(ks[5], (DEPTH, DEC_BATCH, CONV_K - 1, CONV_WIDTH), 1.0),
        'ffn1_norm': 1.0 + nrm(ks[6], (DEPTH, D_MODEL), 0.05),
        'ffn1_w_in': nrm(ks[7], (DEPTH, D_MODEL, 2 * D_FF), D_MODEL ** -0.5),
        'ffn1_w_out': nrm(ks[8], (DEPTH, D_FF, D_MODEL), D_FF ** -0.5),
        'mix_norm': 1.0 + nrm(ks[9], (DEPTH, D_MODEL), 0.05),
        'mix_w_in': nrm(ks[10], (DEPTH, D_MODEL, IN_WIDTH), D_MODEL ** -0.5),
        'gate_b': nrm(ks[11], (DEPTH, N_BRANCH * D_MODEL), 0.1),
        'q_norm': 1.0 + nrm(ks[12], (DEPTH, HEAD_DIM), 0.05),
        'k_norm': 1.0 + nrm(ks[13], (DEPTH, HEAD_DIM), 0.05),
        'rel_bias': nrm(ks[14], (DEPTH, N_HEADS, 2 * REL_CLIP + 1), 0.2),
        'pool_w': nrm(ks[15], (DEPTH, N_POOL_GROUPS, POOL_GROUP, POOL_GROUP), POOL_GROUP ** -0.5),
        'pool_scale': 1.0 + nrm(ks[16], (DEPTH, POOL_WIDTH), 0.05),
        'conv_w': nrm(ks[17], (DEPTH, CONV_K, CONV_WIDTH), CONV_K ** -0.5),
        'conv_b': nrm(ks[18], (DEPTH, CONV_WIDTH), 0.02),
        'w_branch_attn': nrm(ks[19], (DEPTH, ATTN_WIDTH, D_MODEL), ATTN_WIDTH ** -0.5),
        'w_branch_pool': nrm(ks[20], (DEPTH, POOL_WIDTH, D_MODEL), POOL_WIDTH ** -0.5),
        'w_branch_conv': nrm(ks[21], (DEPTH, CONV_WIDTH, D_MODEL), CONV_WIDTH ** -0.5),
        'w_out': nrm(ks[22], (DEPTH, D_MODEL, D_MODEL), D_MODEL ** -0.5),
        'ffn2_norm': 1.0 + nrm(ks[23], (DEPTH, D_MODEL), 0.05),
        'ffn2_w_in': nrm(ks[24], (DEPTH, D_MODEL, 2 * D_FF), D_MODEL ** -0.5),
        'ffn2_w_out': nrm(ks[25], (DEPTH, D_FF, D_MODEL), D_FF ** -0.5),
    }


def reference(x_prompt, x_sample, cache_attn_k, cache_attn_v, state_pool, state_conv,
              ffn1_norm, ffn1_w_in, ffn1_w_out, mix_norm, mix_w_in, gate_b, q_norm, k_norm,
              rel_bias, pool_w, pool_scale, conv_w, conv_b, w_branch_attn, w_branch_pool,
              w_branch_conv, w_out, ffn2_norm, ffn2_w_in, ffn2_w_out):
    B = x_prompt.shape[0]
    pool_h0 = jnp.zeros((B, POOL_HIST, POOL_WIDTH), x_prompt.dtype)
    conv_h0 = jnp.zeros((B, CONV_K - 1, CONV_WIDTH), x_prompt.dtype)
    xp, xs = x_prompt, x_sample
    kp_l, vp_l, pp_l, cp_l = [], [], [], []
    ks_l, vs_l, ps_l, cs_l = [], [], [], []
    for l in range(DEPTH):
        w = dict(ffn1_norm=ffn1_norm[l], ffn1_w_in=ffn1_w_in[l], ffn1_w_out=ffn1_w_out[l],
                 mix_norm=mix_norm[l], mix_w_in=mix_w_in[l], gate_b=gate_b[l],
                 q_norm=q_norm[l], k_norm=k_norm[l], rel_bias=rel_bias[l],
                 pool_w=pool_w[l], pool_scale=pool_scale[l], conv_w=conv_w[l], conv_b=conv_b[l],
                 w_branch_attn=w_branch_attn[l], w_branch_pool=w_branch_pool[l],
                 w_branch_conv=w_branch_conv[l], w_out=w_out[l],
                 ffn2_norm=ffn2_norm[l], ffn2_w_in=ffn2_w_in[l], ffn2_w_out=ffn2_w_out[l])
        xp, kp, vp, pp, cp = trunk_layer(xp, None, pool_h0, conv_h0, 0, w)
        xs, k_s, v_s, p_s, c_s = trunk_layer(xs, (cache_attn_k[l], cache_attn_v[l]),
                                            state_pool[l], state_conv[l], PAST_LEN, w)
        kp_l.append(kp); vp_l.append(vp); pp_l.append(pp); cp_l.append(cp)
        ks_l.append(k_s); vs_l.append(v_s); ps_l.append(p_s); cs_l.append(c_s)
    return (xp, xs,
            jnp.stack(kp_l), jnp.stack(vp_l), jnp.stack(pp_l), jnp.stack(cp_l),
            jnp.stack(ks_l), jnp.stack(vs_l), jnp.stack(ps_l), jnp.stack(cs_l))
```

```cpp
#include <hip/hip_runtime.h>
#include <hip/hip_cooperative_groups.h>
#include <cstdio>
#include <cstdint>
namespace cg = cooperative_groups;

#ifndef PHMASK
#define PHMASK 63
#endif
#ifndef MIXMASK
#define MIXMASK 7
#endif
#ifndef PROBE_G
#define PROBE_G 0
#endif
#ifndef PROBE_M
#define PROBE_M 0
#endif
#ifndef PROBE_NOG
#define PROBE_NOG 0
#endif
#ifndef REPEAT
#define REPEAT 0
#endif
#ifndef DEFER_S
#define DEFER_S 1
#endif
#ifndef MK_ONE_LAUNCH
#define MK_ONE_LAUNCH 1
#endif

#define LAS __attribute__((address_space(3)))
typedef unsigned short bf16_t;
typedef short bf16x8 __attribute__((ext_vector_type(8)));
typedef short s16x4 __attribute__((ext_vector_type(4)));
typedef float f32x4 __attribute__((ext_vector_type(4)));
typedef unsigned u32x4 __attribute__((ext_vector_type(4)));
typedef unsigned u32x2 __attribute__((ext_vector_type(2)));

constexpr int TP = 16384, TS = 512, T = TP + TS, D = 1024, FF = 2816, NIN = 5632, DEPTH = 4;
constexpr int NBATCH = 32, SL = 16, RC = 512;
constexpr float EPS = 1e-6f;
constexpr size_t O_KP = (size_t)T * D, O_VP = O_KP + 1048576, O_PP = O_VP + 1048576, O_CP = O_PP + 15360, O_KS = O_CP + 2048,
                 O_VS = O_KS + 1048576, O_PS = O_VS + 1048576, O_CS = O_PS + 491520, O_END = O_CS + 65536;
constexpr size_t MiB = 1u << 20;
constexpr size_t WS_SSQ = 584 * MiB;
constexpr size_t WS_W = 1 * MiB, LAYER_W_ELEMS = 25165824;
constexpr size_t W_1IN = 0, W_1OUT = 5767168, W_MIX = 8650752, W_BR = 14417920, W_O = 15466496, W_2IN = 16515072, W_2OUT = 22282240;
constexpr size_t WS_XB = 193 * MiB, WS_ACT = 226 * MiB, WS_Q = 317 * MiB, WS_K = 334 * MiB, WS_V = 351 * MiB, WS_PU = 368 * MiB, WS_CIN = 385 * MiB,
                 WS_CB = 402 * MiB, WS_G = 419 * MiB, WS_OC = 518 * MiB, WS_MB = 551 * MiB, WS_VT = 598 * MiB, WS_SLAB = 615 * MiB, WS_END = 637 * MiB;
constexpr int LDS_BYTES = 147456;

struct Args {
    const float* in[26];
    float* out; unsigned char* ws;
    int ph_lo, ph_hi;
};

typedef float f32x2_t __attribute__((ext_vector_type(2)));
typedef __bf16 bf16x2_t __attribute__((ext_vector_type(2)));
__device__ __forceinline__ unsigned cvt_pk_bf16(float lo, float hi) { const f32x2_t v = {lo, hi}; return __builtin_bit_cast(unsigned, __builtin_convertvector(v, bf16x2_t)); }
__device__ __forceinline__ float bf_lo(unsigned w) { return __uint_as_float(w << 16); }
__device__ __forceinline__ float bf_hi(unsigned w) { return __uint_as_float(w & 0xffff0000u); }
__device__ __forceinline__ float fast_sigmoid(float y) { return __builtin_amdgcn_rcpf(1.0f + __expf(-y)); }

__device__ __forceinline__ float row_rstd(const float* part, int row) {
    const f32x4* p = (const f32x4*)(part + (size_t)row * 16);
    const f32x4 a = p[0], b = p[1], c = p[2], d = p[3];
    const float s = ((a[0] + a[1]) + (a[2] + a[3])) + ((b[0] + b[1]) + (b[2] + b[3])) + ((c[0] + c[1]) + (c[2] + c[3])) + ((d[0] + d[1]) + (d[2] + d[3]));
    return __builtin_amdgcn_rsqf(s * (1.0f / 1024.0f) + 1e-6f);
}

namespace pg8 {
constexpr int BM = 256, BK = 64, HALF = 128, HTB = HALF * BK * 2, STAGE_BYTES = 8 * HTB, NXCD = 8, WGM = 2;
__host__ __device__ __forceinline__ int lds_byte(int r, int c) { const int st = (r >> 4) * 2 + (c >> 5), rr = r & 15, cc = c & 31, ob = rr * 64 + cc * 2; return st * 1024 + (ob ^ (((ob >> 9) & 1) << 5)); }
__host__ __device__ __forceinline__ void stage_rc(int b, int& R, int& C) { const int st = b / 1024, sb = b % 1024, swz = sb ^ (((sb >> 9) & 1) << 5); R = (st >> 1) * 16 + swz / 64; C = (st & 1) * 32 + (swz % 64) / 2; }
__host__ __device__ __forceinline__ int perm32(int rho) { const int n = rho >> 4, i = rho & 15; return 8 * (i >> 2) + 4 * n + (i & 3); }

struct Unit { int pm, pn, ks, nt, kb; };
struct Gemm { const bf16_t* A; const bf16_t* Bt; int K; };

struct StaticOrder {
    int nM, nN, nwg, G, c;
    __device__ void init(int M, int N, int G_, int c_) { nM = M / BM; nN = N / BM; nwg = nM * nN; G = G_; c = c_; }
    __device__ bool next(int i, Unit& u) const {
        const long L = (long)i * G + c; if (L >= nwg) return false;
        int wgid = (int)L; { const int q = nwg / NXCD, r = nwg % NXCD, xcd = wgid % NXCD, off = wgid / NXCD; wgid = (xcd < r ? xcd * (q + 1) : r * (q + 1) + (xcd - r) * q) + off; }
        const int nig = WGM * nN, gid = wgid / nig, fm = gid * WGM, gsz = (nM - fm) < WGM ? (nM - fm) : WGM;
        u.pm = fm + ((wgid % nig) % gsz); u.pn = (wgid % nig) / gsz; u.ks = -1; u.nt = 0; u.kb = 0; return true;
    }
    unsigned* sready = nullptr; unsigned expect = 0;
    __device__ __forceinline__ void a_ready(const Unit& u) const {
        if (sready == nullptr || u.pm < 64) return;
        if (threadIdx.x == 0) {
            unsigned sp = 0;
            while (__hip_atomic_load(sready, __ATOMIC_RELAXED, __HIP_MEMORY_SCOPE_AGENT) < expect) { __builtin_amdgcn_s_sleep(2); if (++sp > (1u << 22)) break; }
            __builtin_amdgcn_fence(__ATOMIC_ACQUIRE, "agent");
            asm volatile("s_waitcnt vmcnt(0)" ::: "memory");
        }
        __builtin_amdgcn_s_barrier(); asm volatile("" ::: "memory");
    }
};

struct SplitOrder {
    StaticOrder P; int c, KS;
    __device__ void init(int N, int G_, int c_, int KS_) { P.init(TP, N, G_, c_); c = c_; KS = KS_; }
    __device__ bool next(int i, Unit& u) const {
        if (i == 0) return P.next(0, u);
        if (i > 1 || c >= 8 * KS) return false;
        const int tile = c / KS; u.pm = 64 + (tile & 1); u.pn = tile >> 1; u.ks = c - tile * KS; u.nt = 4; u.kb = u.ks * 512; return true;
    }
    __device__ __forceinline__ void a_ready(const Unit&) const {}
};
struct POrder {
    StaticOrder P;
    __device__ void init(int N, int G_, int c_) { P.init(TP, N, G_, c_); }
    __device__ bool next(int i, Unit& u) const { return i == 0 ? P.next(0, u) : false; }
    __device__ __forceinline__ void a_ready(const Unit&) const {}
};
struct SliceOrder {
    int j, KS;
    __device__ void init(int G_, int c_, int KS_) { KS = KS_; j = c_ - (G_ - 8 * KS_); }
    __device__ bool next(int i, Unit& u) const {
        if (i > 0 || j < 0) return false;
        const int tile = j / KS; u.pm = 64 + (tile & 1); u.pn = tile >> 1; u.ks = j - tile * KS; u.nt = (KS == 10 && u.ks >= 8) ? 6 : 4; u.kb = (KS == 10 && u.ks == 9) ? 38 * 128 : u.ks * 512; return true;
    }
    __device__ __forceinline__ void a_ready(const Unit&) const {}
};

template <class Epi, class Sched>
__device__ __forceinline__ void gemm_phase(LAS unsigned char* lds, const Gemm g, const Sched& S, const Epi& E) {
    int tid_ = threadIdx.x; asm volatile("" : "+v"(tid_));
    const int tid = tid_, wid = __builtin_amdgcn_readfirstlane(tid >> 6), lane = tid & 63, wr = wid >> 2, wc = wid & 3, fr = lane & 15, fq = lane >> 4;
    const int K = g.K, ntfull = K / BK;
    unsigned voffA[2], voffB[2];
#pragma unroll
    for (int i = 0; i < 2; ++i) { int R, C; stage_rc(tid * 16 + i * 8192, R, C); const int Rb = (R & ~31) + perm32(R & 31);
        voffA[i] = (unsigned)(R * K + C) * 2u; voffB[i] = (unsigned)(Rb * K + C) * 2u; }
    const size_t kstep = (size_t)(BK * 2);
    const size_t hstep = (size_t)HALF * K * 2;
    const size_t tstep = 2 * hstep;
    const unsigned ldsw = (unsigned)wid * 1024u;
    const int aoff = lds_byte(wr * 64 + fr, fq * 8), boff = lds_byte(wc * 32 + fr, fq * 8);
#define PG8_SA(b, h) (((b) * 2 + (h)) * HTB)
#define PG8_SB(b, h) ((4 + (b) * 2 + (h)) * HTB)
#define PG8_STAGE(bufoff, gbase, voff) do { _Pragma("unroll") for (int _i = 0; _i < 2; ++_i) \
        __builtin_amdgcn_global_load_lds((const unsigned*)((const char*)(gbase) + (voff)[_i]), (LAS unsigned*)(lds + (bufoff) + ldsw + _i * 8192), 16, 0, 0); } while (0)
#define PG8_LDA(dst, b, h) do { _Pragma("unroll") for (int m = 0; m < 4; ++m) _Pragma("unroll") for (int k = 0; k < 2; ++k) dst[m][k] = *(const LAS bf16x8*)(lds + PG8_SA(b, h) + aoff + m * 2048 + k * 1024); } while (0)
#define PG8_LDB(dst, b, h) do { _Pragma("unroll") for (int n = 0; n < 2; ++n) _Pragma("unroll") for (int k = 0; k < 2; ++k) dst[n][k] = *(const LAS bf16x8*)(lds + PG8_SB(b, h) + boff + n * 2048 + k * 1024); } while (0)
#define PG8_MMA(ai, bj, At, Bt) do { __builtin_amdgcn_s_setprio(1); _Pragma("unroll") for (int m = 0; m < 4; ++m) _Pragma("unroll") for (int n = 0; n < 2; ++n) _Pragma("unroll") for (int k = 0; k < 2; ++k) \
        acc[ai][bj][m][n] = __builtin_amdgcn_mfma_f32_16x16x32_bf16(Bt[n][k], At[m][k], acc[ai][bj][m][n], 0, 0, 0); __builtin_amdgcn_s_setprio(0); } while (0)
#define PG8_WAIT_V(n) asm volatile("s_waitcnt vmcnt(" #n ")" ::: "memory")
#define PG8_WAIT_L(n) asm volatile("s_waitcnt lgkmcnt(" #n ")" ::: "memory")
#define PG8_BAR __builtin_amdgcn_s_barrier()
#define PG8_SCHED __builtin_amdgcn_sched_barrier(0)
    Unit cur, nxt; int ui = 0;
    if (!S.next(0, cur)) return;
    S.a_ready(cur);
    f32x4 acc[2][2][4][2];
#pragma unroll
    for (int a = 0; a < 2; ++a)
#pragma unroll
        for (int b = 0; b < 2; ++b)
#pragma unroll
            for (int m = 0; m < 4; ++m)
#pragma unroll
                for (int n = 0; n < 2; ++n) acc[a][b][m][n] = (f32x4){0.f, 0.f, 0.f, 0.f};
    bf16x8 At[4][2], B0[2][2], B1[2][2];
    const char* cA = (const char*)g.A + (size_t)cur.pm * tstep + cur.kb; const char* cB = (const char*)g.Bt + (size_t)cur.pn * tstep + cur.kb;
    PG8_STAGE(PG8_SB(0, 0), cB, voffB); PG8_STAGE(PG8_SB(0, 1), cB + hstep, voffB); PG8_STAGE(PG8_SA(0, 0), cA, voffA); PG8_STAGE(PG8_SA(0, 1), cA + hstep, voffA);
    if (wr == 1) PG8_BAR;
    PG8_WAIT_V(2); PG8_BAR;
    PG8_STAGE(PG8_SB(1, 0), cB + kstep, voffB); PG8_STAGE(PG8_SA(1, 0), cA + kstep, voffA); PG8_STAGE(PG8_SB(1, 1), cB + hstep + kstep, voffB);
    PG8_WAIT_V(6); PG8_BAR;
    for (;;) {
        const bool has_next = S.next(ui + 1, nxt);
        const char* nA = has_next ? (const char*)g.A + (size_t)nxt.pm * tstep + nxt.kb : cA; const char* nB = has_next ? (const char*)g.Bt + (size_t)nxt.pn * tstep + nxt.kb : cB;
        const int nt = cur.nt ? cur.nt : ntfull;
        for (int t = 0; t < nt; t += 2) {
            const bool last = (t == nt - 2);
            if (last && has_next) S.a_ready(nxt);
            const char* a1 = cA + (size_t)(t + 1) * kstep;
            const char* a2 = last ? nA : cA + (size_t)(t + 2) * kstep; const char* b2 = last ? nB : cB + (size_t)(t + 2) * kstep;
            const char* a3 = a2 + kstep; const char* b3 = b2 + kstep;
            if constexpr (Epi::HAS_MID) { if (t == 8 || t == 12) { E.mid(acc, cur, t, wr, wc, fr, fq); PG8_SCHED; } }
            PG8_LDB(B0, 0, 0); PG8_LDB(B1, 0, 1); PG8_SCHED; PG8_LDA(At, 0, 0); PG8_STAGE(PG8_SA(1, 1), a1 + hstep, voffA);
            PG8_WAIT_V(8); PG8_WAIT_L(0); PG8_BAR; PG8_MMA(0, 0, At, B0); PG8_MMA(0, 1, At, B1); PG8_BAR; PG8_SCHED;
            PG8_LDA(At, 0, 1); PG8_STAGE(PG8_SB(0, 0), b2, voffB); PG8_STAGE(PG8_SB(0, 1), b2 + hstep, voffB); PG8_STAGE(PG8_SA(0, 0), a2, voffA);
            PG8_WAIT_V(8); PG8_WAIT_L(0); PG8_BAR; PG8_MMA(1, 0, At, B0); PG8_MMA(1, 1, At, B1); PG8_BAR; PG8_SCHED;
            PG8_LDB(B0, 1, 0); PG8_LDB(B1, 1, 1); PG8_SCHED; PG8_LDA(At, 1, 0); PG8_STAGE(PG8_SA(0, 1), a2 + hstep, voffA);
            PG8_WAIT_V(8); PG8_WAIT_L(0); PG8_BAR; PG8_MMA(0, 0, At, B0); PG8_MMA(0, 1, At, B1); PG8_BAR; PG8_SCHED;
            PG8_LDA(At, 1, 1); PG8_STAGE(PG8_SB(1, 0), b3, voffB); PG8_STAGE(PG8_SB(1, 1), b3 + hstep, voffB); PG8_STAGE(PG8_SA(1, 0), a3, voffA);
            PG8_WAIT_V(8); PG8_WAIT_L(0); PG8_BAR; PG8_MMA(1, 0, At, B0); PG8_MMA(1, 1, At, B1); PG8_BAR; PG8_SCHED;
        }
        if (wr == 0) PG8_BAR;
        E(acc, cur, wr, wc, fr, fq, lds);
        if (!has_next) break;
#pragma unroll
        for (int a = 0; a < 2; ++a)
#pragma unroll
            for (int b = 0; b < 2; ++b)
#pragma unroll
                for (int m = 0; m < 4; ++m)
#pragma unroll
                    for (int n = 0; n < 2; ++n) acc[a][b][m][n] = (f32x4){0.f, 0.f, 0.f, 0.f};
        cur = nxt; cA = nA; cB = nB; ++ui;
        if (wr == 1) PG8_BAR;
    }
    PG8_WAIT_V(0);
    PG8_BAR;
#undef PG8_SA
#undef PG8_SB
#undef PG8_STAGE
#undef PG8_LDA
#undef PG8_LDB
#undef PG8_MMA
#undef PG8_WAIT_V
#undef PG8_WAIT_L
#undef PG8_BAR
#undef PG8_SCHED
}

typedef f32x4 Acc[2][2][4][2];


struct SplitK {
    float* slab; unsigned* cnt; int KS;
    __device__ __forceinline__ void exchange(const Acc& acc, const Unit& u, int wid, int lane) const {
        const int tile = (u.pm - 64) + 2 * u.pn;
        f32x4* dst = (f32x4*)slab + ((size_t)(tile * KS + u.ks) * 8 + wid) * 2048 + lane;
#pragma unroll
        for (int ai = 0; ai < 2; ++ai)
#pragma unroll
            for (int bj = 0; bj < 2; ++bj)
#pragma unroll
                for (int m = 0; m < 4; ++m)
#pragma unroll
                    for (int n = 0; n < 2; ++n) dst[(((ai * 2 + bj) * 4 + m) * 2 + n) * 64] = acc[ai][bj][m][n];
        asm volatile("s_waitcnt vmcnt(0)" ::: "memory");
        __builtin_amdgcn_s_barrier();
        if (wid == 0 && lane == 0) {
            __builtin_amdgcn_fence(__ATOMIC_RELEASE, "agent");
            asm volatile("s_waitcnt vmcnt(0)" ::: "memory");
            (void)__hip_atomic_fetch_add(cnt + tile, 1u, __ATOMIC_RELAXED, __HIP_MEMORY_SCOPE_AGENT);
            unsigned sp = 0;
            while (__hip_atomic_load(cnt + tile, __ATOMIC_RELAXED, __HIP_MEMORY_SCOPE_AGENT) < (unsigned)KS) { __builtin_amdgcn_s_sleep(2); if (++sp > (1u << 22)) break; }
            __builtin_amdgcn_fence(__ATOMIC_ACQUIRE, "agent");
            asm volatile("s_waitcnt vmcnt(0)" ::: "memory");
        }
        __builtin_amdgcn_s_barrier(); asm volatile("" ::: "memory");
    }
    template <int NS> __device__ __forceinline__ f32x4 sum(int tile, int wid, int lane, int q) const {
        const f32x4* p = (const f32x4*)slab + ((size_t)(tile * NS) * 8 + wid) * 2048 + q * 64 + lane;
        f32x4 v[NS];
#pragma unroll
        for (int i = 0; i < NS; ++i) v[i] = p[(size_t)i * 8 * 2048];
        f32x4 t = v[0];
#pragma unroll
        for (int i = 1; i < NS; ++i) t += v[i];
        return t;
    }
    template <int NS, int NQ> __device__ __forceinline__ void sumq(int tile, int wid, int lane, const int (&q)[NQ], f32x4 (&out)[NQ]) const {
        const f32x4* p = (const f32x4*)slab + ((size_t)(tile * NS) * 8 + wid) * 2048 + lane;
        f32x4 v[NQ][NS];
#pragma unroll
        for (int j = 0; j < NQ; ++j)
#pragma unroll
            for (int i = 0; i < NS; ++i) v[j][i] = p[(size_t)i * 8 * 2048 + q[j] * 64];
#pragma unroll
        for (int j = 0; j < NQ; ++j) { f32x4 t = v[j][0];
#pragma unroll
            for (int i = 1; i < NS; ++i) t += v[j][i];
            out[j] = t; }
    }
    __device__ __forceinline__ f32x4 part(int tile, int slice, int wid, int lane, int q) const {
        return *((const f32x4*)slab + ((size_t)(tile * KS + slice) * 8 + wid) * 2048 + q * 64 + lane);
    }
};

struct EpiSwiglu {
    static constexpr bool HAS_MID = false;
    const float* ssq; bf16_t* act;
    __device__ __forceinline__ void operator()(Acc& acc, const Unit& u, int wr, int wc, int fr, int fq, LAS unsigned char* lds) const {
        const int row0 = u.pm * BM + wr * 64 + fr, col = u.pn * 128 + wc * 32 + 8 * fq;
#pragma unroll
        for (int ai = 0; ai < 2; ++ai)
#pragma unroll
            for (int m = 0; m < 4; ++m) {
                const int row = row0 + ai * HALF + m * 16;
                const float rs = row_rstd(ssq, row);
                float o[8];
#pragma unroll
                for (int n = 0; n < 2; ++n)
#pragma unroll
                    for (int i = 0; i < 4; ++i) { const float gv = acc[ai][0][m][n][i] * rs, uv = acc[ai][1][m][n][i] * rs; o[4 * n + i] = gv * fast_sigmoid(gv) * uv; }
                u32x4 w; w.x = cvt_pk_bf16(o[0], o[1]); w.y = cvt_pk_bf16(o[2], o[3]); w.z = cvt_pk_bf16(o[4], o[5]); w.w = cvt_pk_bf16(o[6], o[7]);
                *(u32x4*)(act + (size_t)row * FF + col) = w;
                asm volatile("" ::: "memory");
            }
    }
};

struct EpiResid {
    static constexpr bool HAS_MID = false;
    float* x; bf16_t* xb; float* ssq_out; float scale; SplitK sk;
    __device__ __forceinline__ void group(const f32x4 (&v)[2][2], int row, int col0, int pn, int wc, int fq) const {
        float ss = 0.f;
#pragma unroll
        for (int bj = 0; bj < 2; ++bj) {
            bf16_t* pb = xb + (size_t)row * D + col0 + bj * HALF;
            const u32x4 xo = *(const u32x4*)pb;
            f32x4 a = (f32x4){bf_lo(xo.x), bf_hi(xo.x), bf_lo(xo.y), bf_hi(xo.y)}, b = (f32x4){bf_lo(xo.z), bf_hi(xo.z), bf_lo(xo.w), bf_hi(xo.w)};
            a += v[bj][0] * scale; b += v[bj][1] * scale;
            if (x) { float* p = x + (size_t)row * D + col0 + bj * HALF; *(f32x4*)p = a; *(f32x4*)(p + 4) = b; }
            else {
                ss += (a[0] * a[0] + a[1] * a[1]) + (a[2] * a[2] + a[3] * a[3]) + (b[0] * b[0] + b[1] * b[1]) + (b[2] * b[2] + b[3] * b[3]);
                u32x4 w; w.x = cvt_pk_bf16(a[0], a[1]); w.y = cvt_pk_bf16(a[2], a[3]); w.z = cvt_pk_bf16(b[0], b[1]); w.w = cvt_pk_bf16(b[2], b[3]);
                *(u32x4*)pb = w;
            }
        }
        if (x) return;
        ss += __shfl_xor(ss, 16); ss += __shfl_xor(ss, 32);
        if (fq == 0) ssq_out[(size_t)row * 16 + pn * 4 + wc] = ss;
    }
    __device__ __forceinline__ void operator()(Acc& acc, const Unit& u, int wr, int wc, int fr, int fq, LAS unsigned char* lds) const {
        const int row0 = u.pm * BM + wr * 64 + fr, col0 = u.pn * BM + wc * 32 + 8 * fq;
        if (u.ks >= 0) {
            const int wid = wr * 4 + wc, lane = fq * 16 + fr, tile = (u.pm - 64) + 2 * u.pn;
            sk.exchange(acc, u, wid, lane);
            if (sk.KS >= 10) {
                if (u.ks < 8) {
                    const int ai = u.ks >> 2, m = u.ks & 3;
                    f32x4 v[2][2];
#pragma unroll
                    for (int bj = 0; bj < 2; ++bj) { const int q0 = ((ai * 2 + bj) * 4 + m) * 2; const int qq[2] = {q0, q0 + 1};
                        if (sk.KS == 11) sk.sumq<11, 2>(tile, wid, lane, qq, v[bj]); else sk.sumq<10, 2>(tile, wid, lane, qq, v[bj]); }
                    group(v, row0 + ai * HALF + m * 16, col0, u.pn, wc, fq);
                }
            } else {
#pragma unroll
                for (int pp = 0; pp < 2; ++pp) {
                    const int pair = u.ks * 2 + pp, ai = pair >> 2, m = pair & 3;
                    const int q0 = (ai * 2 * 4 + m) * 2, q1 = ((ai * 2 + 1) * 4 + m) * 2; const int qq[4] = {q0, q0 + 1, q1, q1 + 1};
                    f32x4 t[4]; sk.sumq<4, 4>(tile, wid, lane, qq, t);
                    const f32x4 v[2][2] = {{t[0], t[1]}, {t[2], t[3]}};
                    group(v, row0 + ai * HALF + m * 16, col0, u.pn, wc, fq);
                }
            }
            return;
        }
#pragma unroll
        for (int ai = 0; ai < 2; ++ai)
#pragma unroll
            for (int m = 0; m < 4; ++m) {
                const f32x4 v[2][2] = {{acc[ai][0][m][0], acc[ai][0][m][1]}, {acc[ai][1][m][0], acc[ai][1][m][1]}};
                group(v, row0 + ai * HALF + m * 16, col0, u.pn, wc, fq);
                asm volatile("" ::: "memory");
            }
    }
};

struct EpiMix {
    static constexpr bool HAS_MID = false;
    const float* ssq; const float* qn; const float* kn; const float* gate_b;
    bf16_t *Q, *Kb, *Vb, *G; float *PU, *CIN, *CB;
    float* kout_p; float* vout_p; float* kout_s; float* vout_s;
    float* xprobe; bf16_t* VT;
    __device__ __forceinline__ void operator()(Acc& acc, const Unit& u, int wr, int wc, int fr, int fq, LAS unsigned char* lds) const {
        const int row0 = u.pm * BM + wr * 64 + fr, pn = u.pn;
        const bool tail = u.pm >= 62;
        if (pn < 4) {
            const bool isk = pn >= 2; const float* nw = isk ? kn : qn; const int head = (pn & 1) * 4 + wc;
            float wv[2][8];
#pragma unroll
            for (int bj = 0; bj < 2; ++bj)
#pragma unroll
                for (int j = 0; j < 8; ++j) wv[bj][j] = nw[32 * bj + 8 * fq + j];
            bf16_t* dst = isk ? Kb : Q;
#pragma unroll
            for (int ai = 0; ai < 2; ++ai)
#pragma unroll
                for (int m = 0; m < 4; ++m) {
                    const int row = row0 + ai * HALF + m * 16;
                    const float rs = row_rstd(ssq, row);
                    float v[2][8]; float ss = 0.f;
#pragma unroll
                    for (int bj = 0; bj < 2; ++bj)
#pragma unroll
                        for (int n = 0; n < 2; ++n)
#pragma unroll
                            for (int i = 0; i < 4; ++i) { const float q = acc[ai][bj][m][n][i] * rs; v[bj][4 * n + i] = q; ss += q * q; }
                    ss += __shfl_xor(ss, 16); ss += __shfl_xor(ss, 32);
                    const float hr = __builtin_amdgcn_rsqf(ss * (1.0f / 64.0f) + EPS);
#pragma unroll
                    for (int bj = 0; bj < 2; ++bj) {
#pragma unroll
                        for (int j = 0; j < 8; ++j) v[bj][j] = v[bj][j] * hr * wv[bj][j];
                        u32x4 w; w.x = cvt_pk_bf16(v[bj][0], v[bj][1]); w.y = cvt_pk_bf16(v[bj][2], v[bj][3]); w.z = cvt_pk_bf16(v[bj][4], v[bj][5]); w.w = cvt_pk_bf16(v[bj][6], v[bj][7]);
                        const int c = head * 64 + 32 * bj + 8 * fq;
                        *(u32x4*)(dst + (size_t)row * 512 + c) = w;
                        if (isk && tail) {
                            float* o = (row < TP ? kout_p + (size_t)(row - (TP - 512)) * 512 : kout_s + (size_t)(row - TP) * 512) + c;
                            *(f32x4*)o = (f32x4){v[bj][0], v[bj][1], v[bj][2], v[bj][3]}; *(f32x4*)(o + 4) = (f32x4){v[bj][4], v[bj][5], v[bj][6], v[bj][7]};
                        }
                    }
                    asm volatile("" ::: "memory");
                }
        } else if (pn == 7 || pn == 8) {
            const int c = (pn - 7) * 128 + wc * 32 + 8 * fq;
#pragma unroll
            for (int ai = 0; ai < 2; ++ai)
#pragma unroll
                for (int m = 0; m < 4; ++m) {
                    const int row = row0 + ai * HALF + m * 16;
                    const float rs = row_rstd(ssq, row), rs2 = rs * rs;
                    float* o = CIN + (size_t)row * 256 + c;
                    *(f32x4*)o = acc[ai][0][m][0] * acc[ai][1][m][0] * rs2; *(f32x4*)(o + 4) = acc[ai][0][m][1] * acc[ai][1][m][1] * rs2;
                    asm volatile("" ::: "memory");
                }
        } else if (pn < 10) {
            const int cl = wc * 32 + 8 * fq;
#pragma unroll
            for (int ai = 0; ai < 2; ++ai)
#pragma unroll
                for (int m = 0; m < 4; ++m) {
                    const int row = row0 + ai * HALF + m * 16;
                    const float rs = row_rstd(ssq, row);
#pragma unroll
                    for (int bj = 0; bj < 2; ++bj) {
                        const f32x4 a = acc[ai][bj][m][0] * rs, b = acc[ai][bj][m][1] * rs;
                        const int c = bj * HALF + cl;
                        if (pn < 6) {
                            const int cv = (pn - 4) * 256 + c;
                            u32x4 w; w.x = cvt_pk_bf16(a[0], a[1]); w.y = cvt_pk_bf16(a[2], a[3]); w.z = cvt_pk_bf16(b[0], b[1]); w.w = cvt_pk_bf16(b[2], b[3]);
                            *(u32x4*)(Vb + (size_t)row * 512 + cv) = w;
                            if (tail) { float* o = (row < TP ? vout_p + (size_t)(row - (TP - 512)) * 512 : vout_s + (size_t)(row - TP) * 512) + cv; *(f32x4*)o = a; *(f32x4*)(o + 4) = b; }
                        } else {
                            float* o = (pn == 6 ? PU : CB) + (size_t)row * 256 + c; *(f32x4*)o = a; *(f32x4*)(o + 4) = b;
                        }
                    }
                    asm volatile("" ::: "memory");
                }
        } else {
            const int cg0 = (pn - 10) * 256 + wc * 32 + 8 * fq;
            f32x4 gb[2][2];
#pragma unroll
            for (int bj = 0; bj < 2; ++bj)
#pragma unroll
                for (int n = 0; n < 2; ++n) gb[bj][n] = *(const f32x4*)(gate_b + cg0 + bj * HALF + 4 * n);
#pragma unroll
            for (int ai = 0; ai < 2; ++ai)
#pragma unroll
                for (int m = 0; m < 4; ++m) {
                    const int row = row0 + ai * HALF + m * 16;
                    const float rs = row_rstd(ssq, row);
#pragma unroll
                    for (int bj = 0; bj < 2; ++bj) {
                        const f32x4 a = acc[ai][bj][m][0] * rs + gb[bj][0], b = acc[ai][bj][m][1] * rs + gb[bj][1];
                        u32x4 w; w.x = cvt_pk_bf16(fast_sigmoid(a[0]), fast_sigmoid(a[1])); w.y = cvt_pk_bf16(fast_sigmoid(a[2]), fast_sigmoid(a[3]));
                        w.z = cvt_pk_bf16(fast_sigmoid(b[0]), fast_sigmoid(b[1])); w.w = cvt_pk_bf16(fast_sigmoid(b[2]), fast_sigmoid(b[3]));
                        *(u32x4*)(G + (size_t)row * 3072 + cg0 + bj * HALF) = w;
                        if (PROBE_G && pn >= 18) { float* xo = xprobe + (size_t)row * D + cg0 - 2048 + bj * HALF; *(f32x4*)xo = (f32x4){bf_lo(w.x), bf_hi(w.x), bf_lo(w.y), bf_hi(w.y)}; *(f32x4*)(xo + 4) = (f32x4){bf_lo(w.z), bf_hi(w.z), bf_lo(w.w), bf_hi(w.w)}; }
                    }
                    asm volatile("" ::: "memory");
                }
        }
    }
};

struct EpiBranch {
    static constexpr bool HAS_MID = !PROBE_NOG;
    const bf16_t* G; bf16_t* MB; float* xprobe; SplitK sk;
    __device__ __forceinline__ void mid(Acc& acc, const Unit& u, int t, int wr, int wc, int fr, int fq) const {
        asm volatile("" : "+v"(fr), "+v"(fq));
        const int row0 = u.pm * BM + wr * 64 + fr, col0 = u.pn * BM + wc * 32 + 8 * fq + (t == 8 ? 0 : 1024);
#pragma unroll
        for (int ai = 0; ai < 2; ++ai)
#pragma unroll
            for (int m = 0; m < 4; ++m) {
                const bf16_t* gp = G + (size_t)(row0 + ai * HALF + m * 16) * 3072 + col0;
#pragma unroll
                for (int bj = 0; bj < 2; ++bj) {
                    const u32x4 ga = *(const u32x4*)(gp + bj * HALF), gb = *(const u32x4*)(gp + bj * HALF + 1024);
                    f32x4 r0, r1;
                    r0[0] = bf_lo(ga.x) * __builtin_amdgcn_rcpf(bf_lo(gb.x)); r0[1] = bf_hi(ga.x) * __builtin_amdgcn_rcpf(bf_hi(gb.x));
                    r0[2] = bf_lo(ga.y) * __builtin_amdgcn_rcpf(bf_lo(gb.y)); r0[3] = bf_hi(ga.y) * __builtin_amdgcn_rcpf(bf_hi(gb.y));
                    r1[0] = bf_lo(ga.z) * __builtin_amdgcn_rcpf(bf_lo(gb.z)); r1[1] = bf_hi(ga.z) * __builtin_amdgcn_rcpf(bf_hi(gb.z));
                    r1[2] = bf_lo(ga.w) * __builtin_amdgcn_rcpf(bf_lo(gb.w)); r1[3] = bf_hi(ga.w) * __builtin_amdgcn_rcpf(bf_hi(gb.w));
                    acc[ai][bj][m][0] *= r0; acc[ai][bj][m][1] *= r1;
                }
                asm volatile("" ::: "memory");
            }
    }
    __device__ __forceinline__ void operator()(Acc& acc, const Unit& u, int wr, int wc, int fr, int fq, LAS unsigned char* lds) const {
        const int row0 = u.pm * BM + wr * 64 + fr, col0 = u.pn * BM + wc * 32 + 8 * fq;
        if (u.ks >= 0) {
            const int wid = wr * 4 + wc, lane = fq * 16 + fr, tile = (u.pm - 64) + 2 * u.pn;
            sk.exchange(acc, u, wid, lane);
#pragma unroll
            for (int pp = 0; pp < 2; ++pp) {
                const int pair = u.ks * 2 + pp, ai = pair >> 2, m = pair & 3, row = row0 + ai * HALF + m * 16;
                const bf16_t* gp = G + (size_t)row * 3072 + col0;
#pragma unroll
                for (int bj = 0; bj < 2; ++bj) {
                    const u32x4 g0 = *(const u32x4*)(gp + bj * HALF), g1 = *(const u32x4*)(gp + bj * HALF + 1024), g2 = *(const u32x4*)(gp + bj * HALF + 2048);
                    const int q0 = ((ai * 2 + bj) * 4 + m) * 2;
                    const f32x4 a0 = sk.part(tile, 0, wid, lane, q0) + sk.part(tile, 1, wid, lane, q0), a1 = sk.part(tile, 2, wid, lane, q0), a2 = sk.part(tile, 3, wid, lane, q0);
                    const f32x4 b0 = sk.part(tile, 0, wid, lane, q0 + 1) + sk.part(tile, 1, wid, lane, q0 + 1), b1 = sk.part(tile, 2, wid, lane, q0 + 1), b2 = sk.part(tile, 3, wid, lane, q0 + 1);
                    u32x4 w;
                    w.x = cvt_pk_bf16(bf_lo(g0.x) * a0[0] + bf_lo(g1.x) * a1[0] + bf_lo(g2.x) * a2[0], bf_hi(g0.x) * a0[1] + bf_hi(g1.x) * a1[1] + bf_hi(g2.x) * a2[1]);
                    w.y = cvt_pk_bf16(bf_lo(g0.y) * a0[2] + bf_lo(g1.y) * a1[2] + bf_lo(g2.y) * a2[2], bf_hi(g0.y) * a0[3] + bf_hi(g1.y) * a1[3] + bf_hi(g2.y) * a2[3]);
                    w.z = cvt_pk_bf16(bf_lo(g0.z) * b0[0] + bf_lo(g1.z) * b1[0] + bf_lo(g2.z) * b2[0], bf_hi(g0.z) * b0[1] + bf_hi(g1.z) * b1[1] + bf_hi(g2.z) * b2[1]);
                    w.w = cvt_pk_bf16(bf_lo(g0.w) * b0[2] + bf_lo(g1.w) * b1[2] + bf_lo(g2.w) * b2[2], bf_hi(g0.w) * b0[3] + bf_hi(g1.w) * b1[3] + bf_hi(g2.w) * b2[3]);
                    *(u32x4*)(MB + (size_t)row * D + col0 + bj * HALF) = w;
                }
            }
            return;
        }
#pragma unroll
        for (int ai = 0; ai < 2; ++ai)
#pragma unroll
            for (int m = 0; m < 4; ++m) {
                const int row = row0 + ai * HALF + m * 16;
#pragma unroll
                for (int bj = 0; bj < 2; ++bj) {
                    u32x4 gc = *(const u32x4*)(G + (size_t)row * 3072 + 2048 + col0 + bj * HALF); if (PROBE_NOG) gc = (u32x4){0x3f803f80u, 0x3f803f80u, 0x3f803f80u, 0x3f803f80u};
                    const f32x4 a = acc[ai][bj][m][0], b = acc[ai][bj][m][1];
                    u32x4 w; w.x = cvt_pk_bf16(a[0] * bf_lo(gc.x), a[1] * bf_hi(gc.x)); w.y = cvt_pk_bf16(a[2] * bf_lo(gc.y), a[3] * bf_hi(gc.y));
                    w.z = cvt_pk_bf16(b[0] * bf_lo(gc.z), b[1] * bf_hi(gc.z)); w.w = cvt_pk_bf16(b[2] * bf_lo(gc.w), b[3] * bf_hi(gc.w));
                    *(u32x4*)(MB + (size_t)row * D + col0 + bj * HALF) = w;
                    if (PROBE_M) { float* xo = xprobe + (size_t)row * D + col0 + bj * HALF; *(f32x4*)xo = (f32x4){a[0] * bf_lo(gc.x), a[1] * bf_hi(gc.x), a[2] * bf_lo(gc.y), a[3] * bf_hi(gc.y)}; *(f32x4*)(xo + 4) = (f32x4){b[0] * bf_lo(gc.z), b[1] * bf_hi(gc.z), b[2] * bf_lo(gc.w), b[3] * bf_hi(gc.w)}; }
                }
                asm volatile("" ::: "memory");
            }
    }
};
}

__device__ __forceinline__ float wave_sum(float v) {
#pragma unroll
    for (int o = 1; o < 64; o <<= 1) v += __shfl_xor(v, o);
    return v;
}
__device__ __forceinline__ void tr_item(const float* W, int ldw, int k0s, int c0s, const float* ksc, bf16_t* WT, int ldt, int r0d, int k0d, LAS float* scr, int lane) {
    f32x4 ld[8];
#pragma unroll
    for (int i = 0; i < 8; ++i) ld[i] = *(const f32x4*)(W + (size_t)(k0s + 8 * i + (lane >> 3)) * ldw + c0s + 4 * (lane & 7));
#pragma unroll
    for (int i = 0; i < 8; ++i) { const int kk = 8 * i + (lane >> 3); f32x4 v = ld[i]; if (ksc) v *= ksc[k0s + kk];
        LAS float* d = scr + kk * 33 + 4 * (lane & 7); d[0] = v[0]; d[1] = v[1]; d[2] = v[2]; d[3] = v[3]; }
    asm volatile("s_waitcnt lgkmcnt(0)" ::: "memory");
    const int c = lane & 7;
#pragma unroll
    for (int j = 0; j < 4; ++j) { const int n = (lane >> 3) + 8 * j; const LAS float* s = scr + (8 * c) * 33 + n;
        u32x4 o; o.x = cvt_pk_bf16(s[0 * 33], s[1 * 33]); o.y = cvt_pk_bf16(s[2 * 33], s[3 * 33]); o.z = cvt_pk_bf16(s[4 * 33], s[5 * 33]); o.w = cvt_pk_bf16(s[6 * 33], s[7 * 33]);
        *(u32x4*)(WT + (size_t)(r0d + n) * ldt + k0d + 8 * c) = o; }
    asm volatile("s_waitcnt lgkmcnt(0)" ::: "memory");
}
__device__ __forceinline__ void fold_pool_item(const float* pw, const float* psc, const float* Wp, int c0, bf16_t* WT, int k0d, LAS float* scr, int lane) {
    const int n = lane & 31, hf = lane >> 5;
    float wp[64];
#pragma unroll
    for (int e = 0; e < 64; ++e) wp[e] = Wp[(size_t)e * D + c0 + n] * psc[e];
    for (int cc = hf * 32; cc < hf * 32 + 32; ++cc) {
        const f32x4* pr = (const f32x4*)(pw + cc * 64); float acc = 0.f;
#pragma unroll
        for (int q = 0; q < 16; ++q) { const f32x4 p4 = pr[q]; acc += p4[0] * wp[4 * q] + p4[1] * wp[4 * q + 1] + p4[2] * wp[4 * q + 2] + p4[3] * wp[4 * q + 3]; }
        scr[cc * 33 + n] = acc;
    }
    asm volatile("s_waitcnt lgkmcnt(0)" ::: "memory");
    const int c = lane & 7;
#pragma unroll
    for (int j = 0; j < 4; ++j) { const int nn = (lane >> 3) + 8 * j; const LAS float* sx = scr + (8 * c) * 33 + nn;
        u32x4 o; o.x = cvt_pk_bf16(sx[0 * 33], sx[1 * 33]); o.y = cvt_pk_bf16(sx[2 * 33], sx[3 * 33]); o.z = cvt_pk_bf16(sx[4 * 33], sx[5 * 33]); o.w = cvt_pk_bf16(sx[6 * 33], sx[7 * 33]);
        *(u32x4*)(WT + (size_t)(c0 + nn) * D + k0d + 8 * c) = o; }
    asm volatile("s_waitcnt lgkmcnt(0)" ::: "memory");
}
__device__ __forceinline__ int mixcol(int c) {
    const int pn = c >> 8, cc = c & 255, bj = cc >> 7, wc = (cc >> 5) & 3;
    if (pn < 4) return pn * 256 + wc * 64 + bj * 32;
    if (pn == 7 || pn == 8) return (bj ? 2304 : 1792) + (pn - 7) * 128 + (cc & 127);
    if (pn == 9) return 2048 + cc;
    return c;
}
__device__ __forceinline__ void prologue(const Args& a, LAS unsigned char* lds, int bid, int gdim) {
    int tid_ = threadIdx.x; asm volatile("" : "+v"(tid_));
    const int tid = tid_, lane = tid & 63, wave = tid >> 6;
    LAS float* scr = (LAS float*)(lds + wave * 16384);
    const int gw = bid * 8 + wave, NGW = gdim * 8;
    constexpr int PER_LAYER = 12288;
    for (int it = gw; it < DEPTH * PER_LAYER; it += NGW) {
        const int l = it / PER_LAYER; int r = it % PER_LAYER;
        bf16_t* WL = (bf16_t*)(a.ws + WS_W) + (size_t)l * LAYER_W_ELEMS;
        if (r < 2816) { const int kb = r / 176, c = (r % 176) * 32; const int src = ((c >> 7) & 1) * FF + (c >> 8) * 128 + (c & 127);
            tr_item(a.in[7] + (size_t)l * D * NIN, NIN, kb * 64, src, a.in[6] + l * D, WL + W_1IN, D, c, kb * 64, scr, lane); continue; }
        r -= 2816;
        if (r < 1408) { const int kb = r / 32, c = (r % 32) * 32; tr_item(a.in[8] + (size_t)l * FF * D, D, kb * 64, c, nullptr, WL + W_1OUT, FF, c, kb * 64, scr, lane); continue; }
        r -= 1408;
        if (r < 2816) { const int kb = r / 176, c = (r % 176) * 32; tr_item(a.in[10] + (size_t)l * D * NIN, NIN, kb * 64, mixcol(c), a.in[9] + l * D, WL + W_MIX, D, c, kb * 64, scr, lane); continue; }
        r -= 2816;
        if (r < 512) {
            if (r < 256) { const int kb = r / 32, c = (r % 32) * 32; tr_item(a.in[19] + (size_t)l * 512 * D, D, kb * 64, c, nullptr, WL + W_BR, D, c, kb * 64, scr, lane); }
            else if (r < 384) { r -= 256; fold_pool_item(a.in[15] + (size_t)(l * 4 + r / 32) * 4096, a.in[16] + l * 256 + (r / 32) * 64, a.in[20] + (size_t)l * 256 * D + (size_t)(r / 32) * 64 * D, (r % 32) * 32, WL + W_BR, 512 + (r / 32) * 64, scr, lane); }
            else { r -= 384; const int kb = r / 32, c = (r % 32) * 32; tr_item(a.in[21] + (size_t)l * 256 * D, D, kb * 64, c, nullptr, WL + W_BR, D, c, 768 + kb * 64, scr, lane); }
            continue; }
        r -= 512;
        if (r < 512) { const int kb = r / 32, c = (r % 32) * 32; tr_item(a.in[22] + (size_t)l * D * D, D, kb * 64, c, nullptr, WL + W_O, D, c, kb * 64, scr, lane); continue; }
        r -= 512;
        if (r < 2816) { const int kb = r / 176, c = (r % 176) * 32; const int src = ((c >> 7) & 1) * FF + (c >> 8) * 128 + (c & 127);
            tr_item(a.in[24] + (size_t)l * D * NIN, NIN, kb * 64, src, a.in[23] + l * D, WL + W_2IN, D, c, kb * 64, scr, lane); continue; }
        r -= 2816;
        { const int kb = r / 32, c = (r % 32) * 32; tr_item(a.in[25] + (size_t)l * FF * D, D, kb * 64, c, nullptr, WL + W_2OUT, FF, c, kb * 64, scr, lane); }
    }
    float* ssq = (float*)(a.ws + WS_SSQ); bf16_t* XB = (bf16_t*)(a.ws + WS_XB);
    for (int row = gw; row < T; row += NGW) {
        const float* src = row < TP ? a.in[0] + (size_t)row * D : a.in[1] + (size_t)(row - TP) * D;
        float s = 0.f;
#pragma unroll
        for (int j = 0; j < 4; ++j) { const f32x4 v = *(const f32x4*)(src + 4 * lane + 256 * j); s += (v[0] * v[0] + v[1] * v[1]) + (v[2] * v[2] + v[3] * v[3]);
            u32x2 w; w.x = cvt_pk_bf16(v[0], v[1]); w.y = cvt_pk_bf16(v[2], v[3]); *(u32x2*)(XB + (size_t)row * D + 4 * lane + 256 * j) = w; }
        s = wave_sum(s);
        if (lane < 16) ssq[(size_t)row * 16 + lane] = lane == 0 ? s : 0.f;
    }
}

#define LDS_SYNC() do { asm volatile("s_waitcnt lgkmcnt(0)" ::: "memory"); __builtin_amdgcn_s_barrier(); asm volatile("" ::: "memory"); } while (0)
constexpr int KS_STRIDE = 72, VT_STRIDE = 68;
constexpr int ATT_KS = 0, ATT_VT = 2 * 64 * KS_STRIDE * 2, ATT_BIAS = ATT_VT + 2 * 64 * VT_STRIDE * 2;

template <bool SAMPLE>
__device__ __forceinline__ void attn_unit(const Args& a, LAS unsigned char* lds, int l, int ux) {
    int tid_ = threadIdx.x; asm volatile("" : "+v"(tid_));
    const int tid = tid_, lane = tid & 63, wave = __builtin_amdgcn_readfirstlane(tid >> 6), hl = wave >> 2, qb = wave & 3, fr = lane & 15, fq = lane >> 4;
    const bf16_t* Q = (const bf16_t*)(a.ws + WS_Q); const bf16_t* Kb = (const bf16_t*)(a.ws + WS_K); const bf16_t* Vb = (const bf16_t*)(a.ws + WS_V);
    bf16_t* OC = (bf16_t*)(a.ws + WS_OC);
    const int hp = ux & 3, cb = ux >> 2;
    const int qrow0 = SAMPLE ? TP + cb * SL : cb * 64;
    const int first = SAMPLE ? 0 : (cb < 8 ? 8 - cb : 0);
    const bool active = SAMPLE ? (qb == 0) : true;
    const int h = hp * 2 + hl;
    LAS bf16_t* Ks = (LAS bf16_t*)(lds + ATT_KS); LAS bf16_t* Vt = (LAS bf16_t*)(lds + ATT_VT); LAS float* Bs = (LAS float*)(lds + ATT_BIAS);
    const float* ck = a.in[2] + ((size_t)(l * NBATCH + cb) * RC) * 512; const float* cv = a.in[3] + ((size_t)(l * NBATCH + cb) * RC) * 512;

    LDS_SYNC();
    for (int i = tid; i < 514; i += 512) { const int hh = i / 257, j = i % 257; Bs[hh * 260 + j] = a.in[14][(size_t)(l * 8 + hp * 2 + hh) * 257 + j]; }
    bf16x8 qf[2];
    if (active) {
        const bf16_t* qp = Q + (size_t)(qrow0 + qb * 16 + fr) * 512 + h * 64 + 8 * fq;
        qf[0] = *(const bf16x8*)qp; qf[1] = *(const bf16x8*)(qp + 32);
    }
    f32x4 o[4]; float mrun = -1e30f, lrun = 0.f;
#pragma unroll
    for (int i = 0; i < 4; ++i) o[i] = (f32x4){0.f, 0.f, 0.f, 0.f};

    u32x4 kr[2], vr[2]; f32x4 kf[2][2], vf[2][2];
    auto issue = [&](int ti) {
        if (SAMPLE && ti < 8) {
#pragma unroll
            for (int p = 0; p < 2; ++p) {
                const int idx = tid + p * 512, key = idx >> 4, seg = idx & 15;
                const float* s = ck + (size_t)(ti * 64 + key) * 512 + hp * 128 + seg * 8; kf[p][0] = *(const f32x4*)s; kf[p][1] = *(const f32x4*)(s + 4);
                const int sv = wave + 8 * p; const float* s2 = cv + (size_t)(ti * 64 + lane) * 512 + hp * 128 + sv * 8; vf[p][0] = *(const f32x4*)s2; vf[p][1] = *(const f32x4*)(s2 + 4);
            }
        } else {
            const int tok0 = SAMPLE ? qrow0 : (cb - 8 + ti) * 64;
#pragma unroll
            for (int p = 0; p < 2; ++p) {
                const int idx = tid + p * 512, key = idx >> 4, seg = idx & 15;
                const bool okk = !SAMPLE || key < SL, okv = !SAMPLE || lane < SL;
                kr[p] = okk ? *(const u32x4*)(Kb + (size_t)(tok0 + key) * 512 + hp * 128 + seg * 8) : (u32x4){0u, 0u, 0u, 0u};
                const int sv = wave + 8 * p;
                vr[p] = okv ? *(const u32x4*)(Vb + (size_t)(tok0 + lane) * 512 + hp * 128 + sv * 8) : (u32x4){0u, 0u, 0u, 0u};
            }
        }
    };
    auto commit = [&](int ti) {
        if (SAMPLE && ti < 8) {
#pragma unroll
            for (int p = 0; p < 2; ++p) {
                kr[p].x = cvt_pk_bf16(kf[p][0][0], kf[p][0][1]); kr[p].y = cvt_pk_bf16(kf[p][0][2], kf[p][0][3]); kr[p].z = cvt_pk_bf16(kf[p][1][0], kf[p][1][1]); kr[p].w = cvt_pk_bf16(kf[p][1][2], kf[p][1][3]);
                vr[p].x = cvt_pk_bf16(vf[p][0][0], vf[p][0][1]); vr[p].y = cvt_pk_bf16(vf[p][0][2], vf[p][0][3]); vr[p].z = cvt_pk_bf16(vf[p][1][0], vf[p][1][1]); vr[p].w = cvt_pk_bf16(vf[p][1][2], vf[p][1][3]);
            }
        }
#pragma unroll
        for (int p = 0; p < 2; ++p) {
            const int idx = tid + p * 512, key = idx >> 4, seg = idx & 15;
            *(LAS u32x4*)(Ks + ((seg >> 3) * 64 + key) * KS_STRIDE + (seg & 7) * 8) = kr[p];
            const int sv = wave + 8 * p; LAS bf16_t* vp = Vt + ((sv >> 3) * 64 + (sv & 7) * 8) * VT_STRIDE + lane;
            vp[0 * VT_STRIDE] = (bf16_t)(vr[p].x & 0xffffu); vp[1 * VT_STRIDE] = (bf16_t)(vr[p].x >> 16);
            vp[2 * VT_STRIDE] = (bf16_t)(vr[p].y & 0xffffu); vp[3 * VT_STRIDE] = (bf16_t)(vr[p].y >> 16);
            vp[4 * VT_STRIDE] = (bf16_t)(vr[p].z & 0xffffu); vp[5 * VT_STRIDE] = (bf16_t)(vr[p].z >> 16);
            vp[6 * VT_STRIDE] = (bf16_t)(vr[p].w & 0xffffu); vp[7 * VT_STRIDE] = (bf16_t)(vr[p].w >> 16);
        }
    };

    issue(first);
    for (int ti = first; ti <= 8; ++ti) {
        commit(ti);
        LDS_SYNC();
        if (ti < 8) issue(ti + 1);
        if (active) {
            f32x4 s[4];
#pragma unroll
            for (int kt = 0; kt < 4; ++kt) {
                s[kt] = (f32x4){0.f, 0.f, 0.f, 0.f};
#pragma unroll
                for (int ks = 0; ks < 2; ++ks) {
                    const bf16x8 ka = *(const LAS bf16x8*)(Ks + (hl * 64 + kt * 16 + fr) * KS_STRIDE + ks * 32 + 8 * fq);
                    s[kt] = __builtin_amdgcn_mfma_f32_16x16x32_bf16(ka, qf[ks], s[kt], 0, 0, 0);
                }
            }
            const int qoff = qb * 16 + fr; float mx = -1e30f;
            if (ti >= 6) {
#pragma unroll
                for (int kt = 0; kt < 4; ++kt)
#pragma unroll
                    for (int i = 0; i < 4; ++i) {
                        const int kk = kt * 16 + 4 * fq + i; int rel = (ti - 8) * 64 + kk - qoff; rel = rel < -128 ? -128 : (rel > 128 ? 128 : rel);
                        float v = s[kt][i] * 0.125f + Bs[hl * 260 + rel + 128];
                        if (SAMPLE && ti == 8 && kk >= SL) v = -1e30f;
                        s[kt][i] = v; mx = fmaxf(mx, v);
                    }
            } else {
                const float b0 = Bs[hl * 260];
#pragma unroll
                for (int kt = 0; kt < 4; ++kt)
#pragma unroll
                    for (int i = 0; i < 4; ++i) { const float v = s[kt][i] * 0.125f + b0; s[kt][i] = v; mx = fmaxf(mx, v); }
            }
            mx = fmaxf(mx, __shfl_xor(mx, 16)); mx = fmaxf(mx, __shfl_xor(mx, 32));
            const float mnew = fmaxf(mrun, mx), alpha = __expf(mrun - mnew); mrun = mnew;
            float ps = 0.f;
#pragma unroll
            for (int kt = 0; kt < 4; ++kt)
#pragma unroll
                for (int i = 0; i < 4; ++i) { const float p = __expf(s[kt][i] - mnew); s[kt][i] = p; ps += p; }
            lrun = lrun * alpha + ps;
#pragma unroll
            for (int db = 0; db < 4; ++db) o[db] *= alpha;
            bf16x8 pb[2];
#pragma unroll
            for (int kp = 0; kp < 2; ++kp) {
                u32x4 w; w.x = cvt_pk_bf16(s[2 * kp][0], s[2 * kp][1]); w.y = cvt_pk_bf16(s[2 * kp][2], s[2 * kp][3]);
                w.z = cvt_pk_bf16(s[2 * kp + 1][0], s[2 * kp + 1][1]); w.w = cvt_pk_bf16(s[2 * kp + 1][2], s[2 * kp + 1][3]);
                pb[kp] = __builtin_bit_cast(bf16x8, w);
            }
#pragma unroll
            for (int db = 0; db < 4; ++db)
#pragma unroll
                for (int kp = 0; kp < 2; ++kp) {
                    const LAS bf16_t* vp = Vt + (hl * 64 + db * 16 + fr) * VT_STRIDE + kp * 32 + 4 * fq;
                    const u32x2 v0 = *(const LAS u32x2*)vp, v1 = *(const LAS u32x2*)(vp + 16);
                    u32x4 w; w.x = v0.x; w.y = v0.y; w.z = v1.x; w.w = v1.y;
                    o[db] = __builtin_amdgcn_mfma_f32_16x16x32_bf16(__builtin_bit_cast(bf16x8, w), pb[kp], o[db], 0, 0, 0);
                }
        }
        LDS_SYNC();
    }
    if (active) {
        lrun += __shfl_xor(lrun, 16); lrun += __shfl_xor(lrun, 32);
        const float inv = 1.0f / lrun;
        bf16_t* op = OC + (size_t)(qrow0 + qb * 16 + fr) * D + h * 64 + 4 * fq;
#pragma unroll
        for (int db = 0; db < 4; ++db) { u32x2 w; w.x = cvt_pk_bf16(o[db][0] * inv, o[db][1] * inv); w.y = cvt_pk_bf16(o[db][2] * inv, o[db][3] * inv); *(u32x2*)(op + db * 16) = w; }
    }
}


template <int DB> __device__ __forceinline__ void tr_read4(unsigned addr, u32x2& r0, u32x2& r1, u32x2& r2, u32x2& r3) {
    asm volatile("ds_read_b64_tr_b16 %0, %4 offset:%5\n\tds_read_b64_tr_b16 %1, %4 offset:%6\n\tds_read_b64_tr_b16 %2, %4 offset:%7\n\tds_read_b64_tr_b16 %3, %4 offset:%8\n\ts_waitcnt lgkmcnt(0)"
                 : "=&v"(r0), "=&v"(r1), "=&v"(r2), "=&v"(r3)
                 : "v"(addr), "n"(DB * 32), "n"(DB * 32 + 16 * 144), "n"(DB * 32 + 32 * 144), "n"(DB * 32 + 48 * 144) : "memory");
}

constexpr int PKV_STRIDE = 72, PBUF_BYTES = 2 * (2 * 64 * PKV_STRIDE * 2), PATT_BIAS = 2 * PBUF_BYTES;
__device__ __forceinline__ void attn_unit_p(const Args& a, LAS unsigned char* lds, int l, int ux) {
    int tid_ = threadIdx.x; asm volatile("" : "+v"(tid_));
    const int tid = tid_, lane = tid & 63, wave = __builtin_amdgcn_readfirstlane(tid >> 6), hl = wave >> 2, qb = wave & 3, fr = lane & 15, fq = lane >> 4;
    const bf16_t* Q = (const bf16_t*)(a.ws + WS_Q); const bf16_t* Kb = (const bf16_t*)(a.ws + WS_K); const bf16_t* Vb = (const bf16_t*)(a.ws + WS_V);
    bf16_t* OC = (bf16_t*)(a.ws + WS_OC);
    const int hp = ux & 3, cb = ux >> 2, qrow0 = cb * 64, first = cb < 8 ? 8 - cb : 0, h = hp * 2 + hl;
    LAS float* Bs = (LAS float*)(lds + PATT_BIAS);
    LDS_SYNC();
    for (int i = tid; i < 514; i += 512) { const int hh = i / 257, j = i % 257; Bs[hh * 260 + j] = a.in[14][(size_t)(l * 8 + hp * 2 + hh) * 257 + j]; }
    bf16x8 qf[2];
    { const bf16_t* qp = Q + (size_t)(qrow0 + qb * 16 + fr) * 512 + h * 64 + 8 * fq; qf[0] = *(const bf16x8*)qp; qf[1] = *(const bf16x8*)(qp + 32); }
    f32x4 o[4]; float mrun = -1e30f, lrun = 0.f;
#pragma unroll
    for (int i = 0; i < 4; ++i) o[i] = (f32x4){0.f, 0.f, 0.f, 0.f};
    u32x4 kr[2], vr[2];
#define PA_ISSUE(ti) do { const int cix_ = cb - 8 + (ti); _Pragma("unroll") for (int p = 0; p < 2; ++p) { const int idx = tid + p * 512; \
        kr[p] = *(const u32x4*)(Kb + (size_t)(cix_ * 64 + (idx >> 4)) * 512 + hp * 128 + (idx & 15) * 8); \
        vr[p] = *(const u32x4*)(Vb + (size_t)(cix_ * 64 + (idx >> 4)) * 512 + hp * 128 + (idx & 15) * 8); } } while (0)
#define PA_COMMIT(bufb) do { LAS bf16_t* Ks_ = (LAS bf16_t*)(lds + (bufb) * PBUF_BYTES); LAS bf16_t* Vt_ = Ks_ + 2 * 64 * PKV_STRIDE; \
        _Pragma("unroll") for (int p = 0; p < 2; ++p) { const int idx = tid + p * 512; \
        *(LAS u32x4*)(Ks_ + (((idx & 15) >> 3) * 64 + (idx >> 4)) * PKV_STRIDE + (idx & 7) * 8) = kr[p]; \
        *(LAS u32x4*)(Vt_ + (((idx & 15) >> 3) * 64 + (idx >> 4)) * PKV_STRIDE + (idx & 7) * 8) = vr[p]; } } while (0)
    PA_ISSUE(first); PA_COMMIT(0);
    if (first < 8) PA_ISSUE(first + 1);
    LDS_SYNC();
    for (int ti = first; ti <= 8; ++ti) {
        const int bsel = (ti - first) & 1;
        const LAS bf16_t* Ks = (const LAS bf16_t*)(lds + bsel * PBUF_BYTES); const LAS bf16_t* Vt = Ks + 2 * 64 * PKV_STRIDE;
        f32x4 s[4];
#pragma unroll
        for (int kt = 0; kt < 4; ++kt) {
            s[kt] = (f32x4){0.f, 0.f, 0.f, 0.f};
#pragma unroll
            for (int ks = 0; ks < 2; ++ks) {
                const bf16x8 ka = *(const LAS bf16x8*)(Ks + (hl * 64 + kt * 16 + fr) * PKV_STRIDE + ks * 32 + 8 * fq);
                s[kt] = __builtin_amdgcn_mfma_f32_16x16x32_bf16(ka, qf[ks], s[kt], 0, 0, 0);
            }
        }
        const int qoff = qb * 16 + fr; float mx = -1e30f;
        if (ti >= 6) {
#pragma unroll
            for (int kt = 0; kt < 4; ++kt)
#pragma unroll
                for (int i = 0; i < 4; ++i) {
                    const int kk = kt * 16 + 4 * fq + i; int rel = (ti - 8) * 64 + kk - qoff; rel = rel < -128 ? -128 : (rel > 128 ? 128 : rel);
                    const float v = s[kt][i] * 0.125f + Bs[hl * 260 + rel + 128];
                    s[kt][i] = v; mx = fmaxf(mx, v);
                }
        } else {
            const float b0 = Bs[hl * 260];
#pragma unroll
            for (int kt = 0; kt < 4; ++kt)
#pragma unroll
                for (int i = 0; i < 4; ++i) { const float v = s[kt][i] * 0.125f + b0; s[kt][i] = v; mx = fmaxf(mx, v); }
        }
        mx = fmaxf(mx, __shfl_xor(mx, 16)); mx = fmaxf(mx, __shfl_xor(mx, 32));
        const float mnew = fmaxf(mrun, mx), alpha = __expf(mrun - mnew); mrun = mnew;
        float ps = 0.f;
#pragma unroll
        for (int kt = 0; kt < 4; ++kt)
#pragma unroll
            for (int i = 0; i < 4; ++i) { const float p = __expf(s[kt][i] - mnew); s[kt][i] = p; ps += p; }
        lrun = lrun * alpha + ps;
#pragma unroll
        for (int db = 0; db < 4; ++db) o[db] *= alpha;
        bf16x8 pb[2];
#pragma unroll
        for (int kp = 0; kp < 2; ++kp) {
            u32x4 w; w.x = cvt_pk_bf16(s[2 * kp][0], s[2 * kp][1]); w.y = cvt_pk_bf16(s[2 * kp][2], s[2 * kp][3]);
            w.z = cvt_pk_bf16(s[2 * kp + 1][0], s[2 * kp + 1][1]); w.w = cvt_pk_bf16(s[2 * kp + 1][2], s[2 * kp + 1][3]);
            pb[kp] = __builtin_bit_cast(bf16x8, w);
        }
        {
            const unsigned vaddr = (unsigned)(size_t)(Vt + (hl * 64 + 4 * fq + (fr >> 2)) * PKV_STRIDE + 4 * (fr & 3));
            u32x2 r0, r1, r2, r3; u32x4 w;
            tr_read4<0>(vaddr, r0, r1, r2, r3);
            w.x = r0.x; w.y = r0.y; w.z = r1.x; w.w = r1.y; o[0] = __builtin_amdgcn_mfma_f32_16x16x32_bf16(__builtin_bit_cast(bf16x8, w), pb[0], o[0], 0, 0, 0);
            w.x = r2.x; w.y = r2.y; w.z = r3.x; w.w = r3.y; o[0] = __builtin_amdgcn_mfma_f32_16x16x32_bf16(__builtin_bit_cast(bf16x8, w), pb[1], o[0], 0, 0, 0);
            tr_read4<1>(vaddr, r0, r1, r2, r3);
            w.x = r0.x; w.y = r0.y; w.z = r1.x; w.w = r1.y; o[1] = __builtin_amdgcn_mfma_f32_16x16x32_bf16(__builtin_bit_cast(bf16x8, w), pb[0], o[1], 0, 0, 0);
            w.x = r2.x; w.y = r2.y; w.z = r3.x; w.w = r3.y; o[1] = __builtin_amdgcn_mfma_f32_16x16x32_bf16(__builtin_bit_cast(bf16x8, w), pb[1], o[1], 0, 0, 0);
            tr_read4<2>(vaddr, r0, r1, r2, r3);
            w.x = r0.x; w.y = r0.y; w.z = r1.x; w.w = r1.y; o[2] = __builtin_amdgcn_mfma_f32_16x16x32_bf16(__builtin_bit_cast(bf16x8, w), pb[0], o[2], 0, 0, 0);
            w.x = r2.x; w.y = r2.y; w.z = r3.x; w.w = r3.y; o[2] = __builtin_amdgcn_mfma_f32_16x16x32_bf16(__builtin_bit_cast(bf16x8, w), pb[1], o[2], 0, 0, 0);
            tr_read4<3>(vaddr, r0, r1, r2, r3);
            w.x = r0.x; w.y = r0.y; w.z = r1.x; w.w = r1.y; o[3] = __builtin_amdgcn_mfma_f32_16x16x32_bf16(__builtin_bit_cast(bf16x8, w), pb[0], o[3], 0, 0, 0);
            w.x = r2.x; w.y = r2.y; w.z = r3.x; w.w = r3.y; o[3] = __builtin_amdgcn_mfma_f32_16x16x32_bf16(__builtin_bit_cast(bf16x8, w), pb[1], o[3], 0, 0, 0);
        }
        if (ti < 8) { PA_COMMIT(bsel ^ 1); if (ti < 7) PA_ISSUE(ti + 2); }
        LDS_SYNC();
    }
#undef PA_ISSUE
#undef PA_COMMIT
    lrun += __shfl_xor(lrun, 16); lrun += __shfl_xor(lrun, 32);
    const float inv = 1.0f / lrun;
    bf16_t* op = OC + (size_t)(qrow0 + qb * 16 + fr) * D + h * 64 + 4 * fq;
#pragma unroll
    for (int db = 0; db < 4; ++db) { u32x2 w; w.x = cvt_pk_bf16(o[db][0] * inv, o[db][1] * inv); w.y = cvt_pk_bf16(o[db][2] * inv, o[db][3] * inv); *(u32x2*)(op + db * 16) = w; }
}

__device__ __forceinline__ void attn_unit_s(const Args& a, LAS unsigned char* lds, int l, int ux) {
    int tid_ = threadIdx.x; asm volatile("" : "+v"(tid_));
    const int tid = tid_, lane = tid & 63, wave = __builtin_amdgcn_readfirstlane(tid >> 6), fr = lane & 15, fq = lane >> 4;
    const bf16_t* Q = (const bf16_t*)(a.ws + WS_Q); const bf16_t* Kb = (const bf16_t*)(a.ws + WS_K); const bf16_t* Vb = (const bf16_t*)(a.ws + WS_V);
    bf16_t* OC = (bf16_t*)(a.ws + WS_OC);
    const int h = ux & 7, b = ux >> 3, qrow0 = TP + b * SL;
    const bool active = wave == 0;
    LAS float* Bs = (LAS float*)(lds + PATT_BIAS);
    const float* ck = a.in[2] + ((size_t)(l * NBATCH + b) * RC) * 512 + h * 64; const float* cv = a.in[3] + ((size_t)(l * NBATCH + b) * RC) * 512 + h * 64;
    LDS_SYNC();
    for (int i = tid; i < 257; i += 512) Bs[i] = a.in[14][(size_t)(l * 8 + h) * 257 + i];
    bf16x8 qf[2];
    if (active) { const bf16_t* qp = Q + (size_t)(qrow0 + fr) * 512 + h * 64 + 8 * fq; qf[0] = *(const bf16x8*)qp; qf[1] = *(const bf16x8*)(qp + 32); }
    f32x4 o[4]; float mrun = -1e30f, lrun = 0.f;
#pragma unroll
    for (int i = 0; i < 4; ++i) o[i] = (f32x4){0.f, 0.f, 0.f, 0.f};
    f32x4 kf[2], vf[2];
#define SA_ISSUE(ti) do { _Pragma("unroll") for (int p = 0; p < 2; ++p) { const int idx = tid + p * 512, key = idx >> 4, seg = idx & 15; \
        if ((ti) < 8) { kf[p] = *(const f32x4*)(ck + (size_t)((ti) * 64 + key) * 512 + seg * 4); vf[p] = *(const f32x4*)(cv + (size_t)((ti) * 64 + key) * 512 + seg * 4); } \
        else if (key < SL) { const u32x2 kw = *(const u32x2*)(Kb + (size_t)(qrow0 + key) * 512 + h * 64 + seg * 4), vw = *(const u32x2*)(Vb + (size_t)(qrow0 + key) * 512 + h * 64 + seg * 4); \
            kf[p] = (f32x4){bf_lo(kw.x), bf_hi(kw.x), bf_lo(kw.y), bf_hi(kw.y)}; vf[p] = (f32x4){bf_lo(vw.x), bf_hi(vw.x), bf_lo(vw.y), bf_hi(vw.y)}; } \
        else { kf[p] = (f32x4){0.f, 0.f, 0.f, 0.f}; vf[p] = (f32x4){0.f, 0.f, 0.f, 0.f}; } } } while (0)
#define SA_COMMIT(bufb) do { LAS bf16_t* Ks_ = (LAS bf16_t*)(lds + (bufb) * PBUF_BYTES); LAS bf16_t* Vt_ = Ks_ + 2 * 64 * PKV_STRIDE; \
        _Pragma("unroll") for (int p = 0; p < 2; ++p) { const int idx = tid + p * 512, key = idx >> 4, seg = idx & 15; \
        u32x2 kw; kw.x = cvt_pk_bf16(kf[p][0], kf[p][1]); kw.y = cvt_pk_bf16(kf[p][2], kf[p][3]); *(LAS u32x2*)(Ks_ + key * PKV_STRIDE + seg * 4) = kw; \
        const unsigned v01 = cvt_pk_bf16(vf[p][0], vf[p][1]), v23 = cvt_pk_bf16(vf[p][2], vf[p][3]); LAS bf16_t* vp_ = Vt_ + (seg * 4) * PKV_STRIDE + key; \
        vp_[0] = (bf16_t)(v01 & 0xffffu); vp_[PKV_STRIDE] = (bf16_t)(v01 >> 16); vp_[2 * PKV_STRIDE] = (bf16_t)(v23 & 0xffffu); vp_[3 * PKV_STRIDE] = (bf16_t)(v23 >> 16); } } while (0)
    SA_ISSUE(0); SA_COMMIT(0); SA_ISSUE(1);
    LDS_SYNC();
    for (int ti = 0; ti <= 8; ++ti) {
        const int bsel = ti & 1;
        if (active) {
            const LAS bf16_t* Ks = (const LAS bf16_t*)(lds + bsel * PBUF_BYTES); const LAS bf16_t* Vt = Ks + 2 * 64 * PKV_STRIDE;
            f32x4 s[4];
#pragma unroll
            for (int kt = 0; kt < 4; ++kt) {
                s[kt] = (f32x4){0.f, 0.f, 0.f, 0.f};
#pragma unroll
                for (int ks = 0; ks < 2; ++ks) {
                    const bf16x8 ka = *(const LAS bf16x8*)(Ks + (kt * 16 + fr) * PKV_STRIDE + ks * 32 + 8 * fq);
                    s[kt] = __builtin_amdgcn_mfma_f32_16x16x32_bf16(ka, qf[ks], s[kt], 0, 0, 0);
                }
            }
            float mx = -1e30f;
            if (ti >= 6) {
#pragma unroll
                for (int kt = 0; kt < 4; ++kt)
#pragma unroll
                    for (int i = 0; i < 4; ++i) {
                        const int kk = kt * 16 + 4 * fq + i; int rel = (ti - 8) * 64 + kk - fr; rel = rel < -128 ? -128 : (rel > 128 ? 128 : rel);
                        float v = s[kt][i] * 0.125f + Bs[rel + 128];
                        if (ti == 8 && kk >= SL) v = -1e30f;
                        s[kt][i] = v; mx = fmaxf(mx, v);
                    }
            } else {
                const float b0 = Bs[0];
#pragma unroll
                for (int kt = 0; kt < 4; ++kt)
#pragma unroll
                    for (int i = 0; i < 4; ++i) { const float v = s[kt][i] * 0.125f + b0; s[kt][i] = v; mx = fmaxf(mx, v); }
            }
            mx = fmaxf(mx, __shfl_xor(mx, 16)); mx = fmaxf(mx, __shfl_xor(mx, 32));
            const float mnew = fmaxf(mrun, mx), alpha = __expf(mrun - mnew); mrun = mnew;
            float ps = 0.f;
#pragma unroll
            for (int kt = 0; kt < 4; ++kt)
#pragma unroll
                for (int i = 0; i < 4; ++i) { const float p = __expf(s[kt][i] - mnew); s[kt][i] = p; ps += p; }
            lrun = lrun * alpha + ps;
#pragma unroll
            for (int db = 0; db < 4; ++db) o[db] *= alpha;
            bf16x8 pb[2];
#pragma unroll
            for (int kp = 0; kp < 2; ++kp) {
                u32x4 w; w.x = cvt_pk_bf16(s[2 * kp][0], s[2 * kp][1]); w.y = cvt_pk_bf16(s[2 * kp][2], s[2 * kp][3]);
                w.z = cvt_pk_bf16(s[2 * kp + 1][0], s[2 * kp + 1][1]); w.w = cvt_pk_bf16(s[2 * kp + 1][2], s[2 * kp + 1][3]);
                pb[kp] = __builtin_bit_cast(bf16x8, w);
            }
#pragma unroll
            for (int db = 0; db < 4; ++db)
#pragma unroll
                for (int kp = 0; kp < 2; ++kp) {
                    const LAS bf16_t* vp = Vt + (db * 16 + fr) * PKV_STRIDE + kp * 32 + 4 * fq;
                    const u32x2 v0 = *(const LAS u32x2*)vp, v1 = *(const LAS u32x2*)(vp + 16);
                    u32x4 w; w.x = v0.x; w.y = v0.y; w.z = v1.x; w.w = v1.y;
                    o[db] = __builtin_amdgcn_mfma_f32_16x16x32_bf16(__builtin_bit_cast(bf16x8, w), pb[kp], o[db], 0, 0, 0);
                }
        }
        if (ti < 8) { SA_COMMIT(bsel ^ 1); if (ti < 7) SA_ISSUE(ti + 2); }
        LDS_SYNC();
    }
#undef SA_ISSUE
#undef SA_COMMIT
    if (active) {
        lrun += __shfl_xor(lrun, 16); lrun += __shfl_xor(lrun, 32);
        const float inv = 1.0f / lrun;
        bf16_t* op = OC + (size_t)(qrow0 + fr) * D + h * 64 + 4 * fq;
#pragma unroll
        for (int db = 0; db < 4; ++db) { u32x2 w; w.x = cvt_pk_bf16(o[db][0] * inv, o[db][1] * inv); w.y = cvt_pk_bf16(o[db][2] * inv, o[db][3] * inv); *(u32x2*)(op + db * 16) = w; }
    }
}

__device__ __forceinline__ void poolconv_unit(const Args& a, int l, int ux) {
    int tid_ = threadIdx.x; asm volatile("" : "+v"(tid_));
    const int tid = tid_, c = tid & 255, half = tid >> 8;
    const float* PU = (const float*)(a.ws + WS_PU); const float* CIN = (const float*)(a.ws + WS_CIN); const float* CB = (const float*)(a.ws + WS_CB);
    bf16_t* OC = (bf16_t*)(a.ws + WS_OC);
    const int t0 = ux * 64 + half * 32; const bool sample = t0 >= TP;
    const int g = c >> 6, w = 2 << g;
    const float cw0 = a.in[17][(size_t)(l * 3 + 0) * 256 + c], cw1 = a.in[17][(size_t)(l * 3 + 1) * 256 + c], cw2 = a.in[17][(size_t)(l * 3 + 2) * 256 + c], cbias = a.in[18][l * 256 + c];
    const float* sp = a.in[4] + (size_t)l * NBATCH * 15 * 256; const float* sc = a.in[5] + (size_t)l * NBATCH * 2 * 256;
    float sum = 0.f, c1 = 0.f, c2 = 0.f;
    if (!sample) {
        for (int k = 1; k < w; ++k) if (t0 - k >= 0) sum += PU[(size_t)(t0 - k) * 256 + c];
        if (t0 >= 1) c1 = CIN[(size_t)(t0 - 1) * 256 + c];
        if (t0 >= 2) c2 = CIN[(size_t)(t0 - 2) * 256 + c];
    }
    for (int jb = 0; jb < 32; jb += 8) {
        float u8[8], ci8[8], cb8[8], od8[8];
#pragma unroll
        for (int q = 0; q < 8; ++q) {
            const int t = t0 + jb + q;
            u8[q] = PU[(size_t)t * 256 + c]; ci8[q] = CIN[(size_t)t * 256 + c]; cb8[q] = CB[(size_t)t * 256 + c];
            if (!sample) od8[q] = (t - w + 1 >= 0) ? PU[(size_t)(t - w + 1) * 256 + c] : 0.f;
            else { const int b = (t - TP) >> 4, e = ((t - TP) & 15) - w + 1; od8[q] = e >= 0 ? PU[(size_t)(t - w + 1) * 256 + c] : sp[(size_t)(b * 15 + 15 + e) * 256 + c]; }
        }
#pragma unroll
        for (int q = 0; q < 8; ++q) {
            const int t = t0 + jb + q; const float u = u8[q], ci = ci8[q];
            float cnt;
            if (!sample) {
                cnt = (float)((t + 1 < w) ? t + 1 : w);
                if (t >= TP - 15) a.out[O_PP + (size_t)l * 3840 + (size_t)(t - (TP - 15)) * 256 + c] = u;
                if (t >= TP - 2) a.out[O_CP + (size_t)l * 512 + (size_t)(t - (TP - 2)) * 256 + c] = ci;
            } else {
                const int b = (t - TP) >> 4, sq = (t - TP) & 15; cnt = (float)w;
                if (sq == 0) {
                    sum = 0.f; for (int k = 1; k < w; ++k) sum += sp[(size_t)(b * 15 + 15 - k) * 256 + c];
                    c1 = sc[(size_t)(b * 2 + 1) * 256 + c]; c2 = sc[(size_t)(b * 2) * 256 + c];
                }
                if (sq >= 1) a.out[O_PS + (size_t)l * 122880 + (size_t)(b * 15 + sq - 1) * 256 + c] = u;
                if (sq >= 14) a.out[O_CS + (size_t)l * 16384 + (size_t)(b * 2 + sq - 14) * 256 + c] = ci;
            }
            sum += u;
            const float dv = sum / cnt - u;
            sum -= od8[q];
            const float y = cbias + cw0 * c2 + cw1 * c1 + cw2 * ci;
            OC[(size_t)t * D + 512 + c] = (bf16_t)(cvt_pk_bf16(dv, 0.f) & 0xffffu);
            OC[(size_t)t * D + 768 + c] = (bf16_t)(cvt_pk_bf16(cb8[q] * y, 0.f) & 0xffffu);
            c2 = c1; c1 = ci;
        }
    }
}

constexpr int N_ATT_P = 1024, N_ATT_S = 256, N_PC = T / 64;
__device__ __forceinline__ void mixer_phase(const Args& a, LAS unsigned char* lds, int l, int bid, int gdim) {
    for (int u = bid; u < N_ATT_P + N_ATT_S + N_PC; u += gdim) {
        if (u < N_ATT_P) { if (MIXMASK & 1) attn_unit_p(a, lds, l, u); if (REPEAT & 128) attn_unit_p(a, lds, l, u); }
        else if (u < N_ATT_P + N_ATT_S) { if (MIXMASK & 2) attn_unit_s(a, lds, l, u - N_ATT_P); if (REPEAT & 256) attn_unit_s(a, lds, l, u - N_ATT_P); }
        else { if (MIXMASK & 4) poolconv_unit(a, l, u - N_ATT_P - N_ATT_S); if (REPEAT & 512) poolconv_unit(a, l, u - N_ATT_P - N_ATT_S); }
    }
    if (MIXMASK & 8) {
        const float* PU = (const float*)(a.ws + WS_PU); const float* CIN = (const float*)(a.ws + WS_CIN); bf16_t* OC = (bf16_t*)(a.ws + WS_OC);
        int tq = threadIdx.x; asm volatile("" : "+v"(tq));
        for (int i = bid * 512 + tq; i < T * 256; i += gdim * 512) { const size_t t = i >> 8, c = i & 255;
            const bf16_t* XBp = (const bf16_t*)(a.ws + WS_XB); bf16_t* MBp = (bf16_t*)(a.ws + WS_OC); MBp[t * D + c] = XBp[t * D + c]; MBp[t * D + 256 + c] = XBp[t * D + 256 + c]; MBp[t * D + 512 + c] = XBp[t * D + 512 + c]; MBp[t * D + 768 + c] = XBp[t * D + 768 + c]; }
    }
    LDS_SYNC();
}

#define XB_TMO      128
#define XB_XCNT(j)  (256  + 64 * (j))
#define XB_XSUB(j)  (1280 + 64 * (j))
#define XB_XGEN(j)  (2304 + 64 * (j))
#define XB_TOP      3328
#define XB_TOPGEN   3392
#define XCD_BAR_WORDS 3456
#define XB_SPIN_CAP (1u << 20)
__device__ __forceinline__ unsigned xb_ld(unsigned* p)              { return __hip_atomic_load(p, __ATOMIC_RELAXED, __HIP_MEMORY_SCOPE_AGENT); }
__device__ __forceinline__ unsigned xb_add(unsigned* p, unsigned v) { return __hip_atomic_fetch_add(p, v, __ATOMIC_RELAXED, __HIP_MEMORY_SCOPE_AGENT); }
__device__ __forceinline__ unsigned xb_xcc_id() { return (unsigned)__builtin_amdgcn_s_getreg((3 << 11) | 20) & 0xFu; }
#define XB_SPIN(cond, bar) do { unsigned _sp = 0; while (cond) { __builtin_amdgcn_s_sleep(1); \
    if ((++_sp & 255u) == 0u) { if (xb_ld(&(bar)[XB_TMO])) break; if (_sp > XB_SPIN_CAP) { atomicAdd(&(bar)[XB_TMO], 1u); break; } } } } while (0)
struct XcdBarrier { unsigned* bar; unsigned x; volatile LAS unsigned* st; };
__device__ __forceinline__ XcdBarrier xcd_barrier_post(unsigned* bar, volatile LAS unsigned* st) {
    XcdBarrier b; b.bar = bar; b.x = xb_xcc_id(); b.st = st;
    if (threadIdx.x == 0) (void)xb_add(&bar[XB_XCNT(b.x)], 1u);
    return b;
}
__device__ __forceinline__ void xcd_barrier_complete(unsigned* bar, unsigned x, unsigned& nloc, unsigned& nx) {
    const unsigned G = gridDim.x * gridDim.y * gridDim.z;
    unsigned sum, cnt, mine, sp = 0u;
    for (;;) {
        sum = 0u; cnt = 0u; mine = 0u;
#pragma unroll
        for (unsigned j = 0; j < 16; ++j) { const unsigned c = xb_ld(&bar[XB_XCNT(j)]); sum += c; cnt += (c > 0u) ? 1u : 0u; mine = (j == x) ? c : mine; }
        if (sum == G) break;
        __builtin_amdgcn_s_sleep(1);
        if ((++sp & 255u) == 0u) { if (xb_ld(&bar[XB_TMO])) break; if (sp > XB_SPIN_CAP) { atomicAdd(&bar[XB_TMO], 1u); break; } }
    }
    nloc = mine > 0u ? mine : 1u; nx = cnt > 0u ? cnt : 1u;
}
__device__ __forceinline__ void xcd_barrier(const XcdBarrier& b) {
    asm volatile("s_waitcnt vmcnt(0)" ::: "memory");
    __syncthreads();
    if (threadIdx.x == 0) {
        unsigned* bar = b.bar;
        __builtin_amdgcn_s_waitcnt(0);
        unsigned nloc = b.st[0], nx = b.st[1];
        if (nloc == 0u) { xcd_barrier_complete(bar, b.x, nloc, nx); b.st[0] = nloc; b.st[1] = nx; }
        const unsigned old = xb_add(&bar[XB_XSUB(b.x)], 1u);
        const unsigned gen = old / nloc;
        if (old + 1u == (gen + 1u) * nloc) {
            __builtin_amdgcn_fence(__ATOMIC_RELEASE, "agent");
            asm volatile("s_waitcnt vmcnt(0)" ::: "memory");
            const unsigned og = xb_add(&bar[XB_TOP], 1u);
            const unsigned tg = og / nx;
            if (og + 1u == (tg + 1u) * nx) xb_add(&bar[XB_TOPGEN], 1u);
            else XB_SPIN(xb_ld(&bar[XB_TOPGEN]) == tg, bar);
            __builtin_amdgcn_fence(__ATOMIC_ACQUIRE, "agent");
            xb_add(&bar[XB_XGEN(b.x)], 1u);
            asm volatile("s_waitcnt vmcnt(0)" ::: "memory");
        } else {
            XB_SPIN(xb_ld(&bar[XB_XGEN(b.x)]) == gen, bar);
            __builtin_amdgcn_fence(__ATOMIC_ACQUIRE, "agent");
            asm volatile("s_waitcnt vmcnt(0)" ::: "memory");
        }
    }
    __syncthreads();
}

constexpr int N_PHASES = 1 + 8 * DEPTH;
__global__ void __launch_bounds__(512, 2) fwd_kernel(Args a) {
    extern __shared__ __attribute__((aligned(16))) unsigned char lds_raw[];
    LAS unsigned char* lds = (LAS unsigned char*)lds_raw;
    unsigned char* ws = a.ws;
    float* ssq = (float*)(ws + WS_SSQ);
    bf16_t* XB = (bf16_t*)(ws + WS_XB); bf16_t* ACT = (bf16_t*)(ws + WS_ACT);
    volatile LAS unsigned* misc = (volatile LAS unsigned*)(lds + 131072 + 1024);
    if (threadIdx.x < 2) misc[threadIdx.x] = 0u;
    __syncthreads();
    const XcdBarrier xbar = xcd_barrier_post((unsigned*)ws, misc);
    for (int ph = a.ph_lo; ph < a.ph_hi; ++ph) {
        int bid = blockIdx.x, gdim = gridDim.x; asm volatile("" : "+s"(bid), "+s"(gdim));
        if (ph == 0) { if (PHMASK & 1) prologue(a, lds, bid, gdim); if (REPEAT & 1) { __syncthreads(); prologue(a, lds, bid, gdim); } asm volatile("s_waitcnt vmcnt(0) lgkmcnt(0)" ::: "memory"); __syncthreads(); }
        else {
            const int l = (ph - 1) >> 3, s = (ph - 1) & 7;
            const bf16_t* WL = (const bf16_t*)(ws + WS_W) + (size_t)l * LAYER_W_ELEMS;
            pg8::StaticOrder S;
            unsigned* const sready_base = (unsigned*)ws + 3840;
            if (DEFER_S && (s == 0 || s == 2 || s == 6) && ph > 1) {
                const int sp = s == 0 ? 7 : s - 1, lp = s == 0 ? l - 1 : l, KSp = sp == 5 ? 4 : 10;
                if (bid >= gdim - 8 * KSp) {
                    const bf16_t* WLp = (const bf16_t*)(ws + WS_W) + (size_t)lp * LAYER_W_ELEMS;
                    pg8::Gemm g2{sp == 5 ? (const bf16_t*)(ws + WS_MB) : ACT, WLp + (sp == 1 ? W_1OUT : (sp == 5 ? W_O : W_2OUT)), sp == 5 ? D : FF};
                    pg8::SliceOrder SL; SL.init(gdim, bid, KSp);
                    pg8::EpiResid E2{nullptr, XB, ssq + (size_t)(3 * lp + (sp == 1 ? 1 : (sp == 5 ? 2 : 3))) * T * 16, sp == 5 ? 1.0f : 0.5f,
                                     pg8::SplitK{(float*)(ws + WS_SLAB), (unsigned*)ws + 3584 + lp * 64 + sp * 8, KSp}};
                    pg8::gemm_phase(lds, g2, SL, E2);
                    asm volatile("s_waitcnt vmcnt(0)" ::: "memory");
                    __syncthreads();
                    if (threadIdx.x == 0) { __builtin_amdgcn_fence(__ATOMIC_RELEASE, "agent"); asm volatile("s_waitcnt vmcnt(0)" ::: "memory");
                        (void)__hip_atomic_fetch_add(sready_base + lp * 4 + (sp == 1 ? 0 : (sp == 5 ? 1 : 2)), 1u, __ATOMIC_RELAXED, __HIP_MEMORY_SCOPE_AGENT); }
                }
                S.sready = sready_base + lp * 4 + (sp == 1 ? 0 : (sp == 5 ? 1 : 2)); S.expect = 8u * (unsigned)KSp;
            }
            if (s == 0 || s == 6) {
                pg8::Gemm g{XB, WL + (s == 0 ? W_1IN : W_2IN), D}; S.init(T, NIN, gdim, bid);
                pg8::EpiSwiglu E{ssq + (size_t)(3 * l + (s == 0 ? 0 : 2)) * T * 16, ACT};
                if (PHMASK & 2) pg8::gemm_phase(lds, g, S, E);
                if (REPEAT & 2) pg8::gemm_phase(lds, g, S, E);
            } else if (s == 1 || s == 5 || s == 7) {
                pg8::Gemm g{s == 5 ? (const bf16_t*)(ws + WS_MB) : ACT, WL + (s == 1 ? W_1OUT : (s == 5 ? W_O : W_2OUT)), s == 5 ? D : FF}; pg8::SplitOrder SO; SO.init(D, gdim, bid, s == 5 ? 4 : 11);
                pg8::EpiResid E{ph == N_PHASES - 1 ? a.out : nullptr, XB, ssq + (size_t)(3 * l + (s == 1 ? 1 : (s == 5 ? 2 : 3))) * T * 16, s == 5 ? 1.0f : 0.5f,
                                 pg8::SplitK{(float*)(ws + WS_SLAB), (unsigned*)ws + 3584 + ((ph - 1) >> 3) * 64 + s * 8, s == 5 ? 4 : 11}};
                if (DEFER_S && ph != N_PHASES - 1) { pg8::POrder PO; PO.init(D, gdim, bid); pg8::gemm_phase(lds, g, PO, E); }
                else pg8::gemm_phase(lds, g, SO, E);
            } else if (s == 2) {
                pg8::Gemm g{XB, WL + W_MIX, D}; S.init(T, NIN, gdim, bid);
                pg8::EpiMix E{ssq + (size_t)(3 * l + 1) * T * 16, a.in[12] + l * 64, a.in[13] + l * 64, a.in[11] + l * 3072,
                              (bf16_t*)(ws + WS_Q), (bf16_t*)(ws + WS_K), (bf16_t*)(ws + WS_V), (bf16_t*)(ws + WS_G), (float*)(ws + WS_PU), (float*)(ws + WS_CIN), (float*)(ws + WS_CB),
                              a.out + O_KP + (size_t)l * 262144, a.out + O_VP + (size_t)l * 262144, a.out + O_KS + (size_t)l * 262144, a.out + O_VS + (size_t)l * 262144, a.out, (bf16_t*)(ws + WS_VT)};
                if (PHMASK & 8) pg8::gemm_phase(lds, g, S, E);
                if (REPEAT & 8) pg8::gemm_phase(lds, g, S, E);
            } else if (s == 3) {
                if (PHMASK & 16) mixer_phase(a, lds, l, bid, gdim);
                if (REPEAT & 16) mixer_phase(a, lds, l, bid, gdim);
            } else {
                pg8::Gemm g{(const bf16_t*)(ws + WS_OC), WL + W_BR, D}; pg8::SplitOrder SO; SO.init(D, gdim, bid, 4);
                pg8::EpiBranch E{(const bf16_t*)(ws + WS_G), (bf16_t*)(ws + WS_MB), a.out, pg8::SplitK{(float*)(ws + WS_SLAB), (unsigned*)ws + 3584 + ((ph - 1) >> 3) * 64 + s * 8, 4}};
                if (PHMASK & 32) pg8::gemm_phase(lds, g, SO, E);
            }
        }
        if (ph + 1 < a.ph_hi) { if (ph == a.ph_lo) cg::this_grid().sync(); else xcd_barrier(xbar); if (REPEAT & 64) xcd_barrier(xbar); }
    }
}

extern "C" void kernel_launch(void* const* d_in, const int* in_sizes, int n_in, void* d_out, int out_size, void* d_ws, size_t ws_size, hipStream_t stream) {
    static int grid = 0;
    if (grid == 0) {
        if (n_in != 26 || out_size != (int)O_END || ws_size < WS_END) { fprintf(stderr, "kernel_launch: unexpected shapes: n_in %d out %d ws %zu\n", n_in, out_size, ws_size); grid = -1; return; }
        int dev = 0, cus = 0, per_cu = 0;
        hipGetDevice(&dev); hipDeviceGetAttribute(&cus, hipDeviceAttributeMultiprocessorCount, dev);
        if (hipFuncSetAttribute((const void*)fwd_kernel, hipFuncAttributeMaxDynamicSharedMemorySize, LDS_BYTES) != hipSuccess) { fprintf(stderr, "kernel_launch: hipFuncSetAttribute failed\n"); grid = -1; return; }
        hipOccupancyMaxActiveBlocksPerMultiprocessor(&per_cu, (const void*)fwd_kernel, 512, LDS_BYTES);
        (void)hipGetLastError();
        if (per_cu < 1) per_cu = 1;
        grid = cus;
        if (cus != 256) { fprintf(stderr, "kernel_launch: built for 256 CUs (one prompt tile per CU in the N = 1024 GEMMs), got %d\n", cus); grid = -1; return; }
        fprintf(stderr, "kernel_launch: cus %d per_cu %d grid %d\n", cus, per_cu, grid);
    }
    if (grid < 0) return;
    Args a{};
    for (int i = 0; i < 26; ++i) a.in[i] = (const float*)d_in[i];
    a.out = (float*)d_out; a.ws = (unsigned char*)d_ws;
    if (hipMemsetAsync(d_ws, 0, 16384, stream) != hipSuccess) { fprintf(stderr, "kernel_launch: memset of the barrier words failed\n"); return; }
#if MK_ONE_LAUNCH
    a.ph_lo = 0; a.ph_hi = N_PHASES;
    void* args[] = {&a};
    hipError_t e = hipLaunchCooperativeKernel((const void*)fwd_kernel, dim3(grid), dim3(512), args, LDS_BYTES, stream);
    if (e != hipSuccess) fprintf(stderr, "cooperative launch failed: %s (grid %d)\n", hipGetErrorString(e), grid);
#else
    for (int ph = 0; ph < N_PHASES; ++ph) {
        a.ph_lo = ph; a.ph_hi = ph + 1;
        hipLaunchKernelGGL(fwd_kernel, dim3(grid), dim3(512), LDS_BYTES, stream, a);
    }
#endif
}
```

```cpp
#include <hip/hip_runtime.h>
#include <hip/hip_cooperative_groups.h>
#include <cstdio>
#include <cstdint>
namespace cg = cooperative_groups;

#ifndef PHMASK
#define PHMASK 63
#endif
#ifndef MIXMASK
#define MIXMASK 7
#endif
#ifndef PROBE_G
#define PROBE_G 0
#endif
#ifndef PROBE_M
#define PROBE_M 0
#endif
#ifndef PROBE_NOG
#define PROBE_NOG 0
#endif
#ifndef REPEAT
#define REPEAT 0
#endif
#ifndef DEFER_S
#define DEFER_S 1
#endif
#ifndef MK_ONE_LAUNCH
#define MK_ONE_LAUNCH 1
#endif

#define LAS __attribute__((address_space(3)))
typedef unsigned short bf16_t;
typedef short bf16x8 __attribute__((ext_vector_type(8)));
typedef short s16x4 __attribute__((ext_vector_type(4)));
typedef float f32x4 __attribute__((ext_vector_type(4)));
typedef unsigned u32x4 __attribute__((ext_vector_type(4)));
typedef unsigned u32x2 __attribute__((ext_vector_type(2)));

constexpr int TP = 16384, TS = 512, T = TP + TS, D = 1024, FF = 2816, NIN = 5632, DEPTH = 4;
constexpr int NBATCH = 32, SL = 16, RC = 512;
constexpr float EPS = 1e-6f;
constexpr size_t O_KP = (size_t)T * D, O_VP = O_KP + 1048576, O_PP = O_VP + 1048576, O_CP = O_PP + 15360, O_KS = O_CP + 2048,
                 O_VS = O_KS + 1048576, O_PS = O_VS + 1048576, O_CS = O_PS + 491520, O_END = O_CS + 65536;
constexpr size_t MiB = 1u << 20;
constexpr size_t WS_SSQ = 584 * MiB;
constexpr size_t WS_W = 1 * MiB, LAYER_W_ELEMS = 25165824;
constexpr size_t W_1IN = 0, W_1OUT = 5767168, W_MIX = 8650752, W_BR = 14417920, W_O = 15466496, W_2IN = 16515072, W_2OUT = 22282240;
constexpr size_t WS_XB = 193 * MiB, WS_ACT = 226 * MiB, WS_Q = 317 * MiB, WS_K = 334 * MiB, WS_V = 351 * MiB, WS_PU = 368 * MiB, WS_CIN = 385 * MiB,
                 WS_CB = 402 * MiB, WS_G = 419 * MiB, WS_OC = 518 * MiB, WS_MB = 551 * MiB, WS_VT = 598 * MiB, WS_SLAB = 615 * MiB, WS_END = 637 * MiB;
constexpr int LDS_BYTES = 147456;

struct Args {
    const float* in[26];
    float* out; unsigned char* ws;
    int ph_lo, ph_hi;
};

typedef float f32x2_t __attribute__((ext_vector_type(2)));
typedef __bf16 bf16x2_t __attribute__((ext_vector_type(2)));
__device__ __forceinline__ unsigned cvt_pk_bf16(float lo, float hi) { const f32x2_t v = {lo, hi}; return __builtin_bit_cast(unsigned, __builtin_convertvector(v, bf16x2_t)); }
__device__ __forceinline__ float bf_lo(unsigned w) { return __uint_as_float(w << 16); }
__device__ __forceinline__ float bf_hi(unsigned w) { return __uint_as_float(w & 0xffff0000u); }
__device__ __forceinline__ float fast_sigmoid(float y) { return __builtin_amdgcn_rcpf(1.0f + __expf(-y)); }

__device__ __forceinline__ float row_rstd(const float* part, int row) {
    const f32x4* p = (const f32x4*)(part + (size_t)row * 16);
    const f32x4 a = p[0], b = p[1], c = p[2], d = p[3];
    const float s = ((a[0] + a[1]) + (a[2] + a[3])) + ((b[0] + b[1]) + (b[2] + b[3])) + ((c[0] + c[1]) + (c[2] + c[3])) + ((d[0] + d[1]) + (d[2] + d[3]));
    return __builtin_amdgcn_rsqf(s * (1.0f / 1024.0f) + 1e-6f);
}

namespace pg8 {
constexpr int BM = 256, BK = 64, HALF = 128, HTB = HALF * BK * 2, STAGE_BYTES = 8 * HTB, NXCD = 8, WGM = 4;
__host__ __device__ __forceinline__ int lds_byte(int r, int c) { const int st = (r >> 4) * 2 + (c >> 5), rr = r & 15, cc = c & 31, ob = rr * 64 + cc * 2; return st * 1024 + (ob ^ (((ob >> 9) & 1) << 5)); }
__host__ __device__ __forceinline__ void stage_rc(int b, int& R, int& C) { const int st = b / 1024, sb = b % 1024, swz = sb ^ (((sb >> 9) & 1) << 5); R = (st >> 1) * 16 + swz / 64; C = (st & 1) * 32 + (swz % 64) / 2; }
__host__ __device__ __forceinline__ int perm32(int rho) { const int n = rho >> 4, i = rho & 15; return 8 * (i >> 2) + 4 * n + (i & 3); }

struct Unit { int pm, pn, ks, nt, kb; };
struct Gemm { const bf16_t* A; const bf16_t* Bt; int K; };

struct StaticOrder {
    int nM, nN, nwg, G, c;
    __device__ void init(int M, int N, int G_, int c_) { nM = M / BM; nN = N / BM; nwg = nM * nN; G = G_; c = c_; }
    __device__ bool next(int i, Unit& u) const {
        const long L = (long)i * G + c; if (L >= nwg) return false;
        int wgid = (int)L; { const int q = nwg / NXCD, r = nwg % NXCD, xcd = wgid % NXCD, off = wgid / NXCD; wgid = (xcd < r ? xcd * (q + 1) : r * (q + 1) + (xcd - r) * q) + off; }
        const int nig = WGM * nN, gid = wgid / nig, fm = gid * WGM, gsz = (nM - fm) < WGM ? (nM - fm) : WGM;
        u.pm = fm + ((wgid % nig) % gsz); u.pn = (wgid % nig) / gsz; if (gid & 1) u.pn = nN - 1 - u.pn;
        u.ks = -1; u.nt = 0; u.kb = 0; return true;
    }
    unsigned* sready = nullptr; unsigned expect = 0;
    __device__ __forceinline__ void a_ready(const Unit& u) const {
        if (sready == nullptr || u.pm < 64) return;
        if (threadIdx.x == 0) {
            unsigned sp = 0;
            while (__hip_atomic_load(sready, __ATOMIC_RELAXED, __HIP_MEMORY_SCOPE_AGENT) < expect) { __builtin_amdgcn_s_sleep(2); if (++sp > (1u << 22)) break; }
            __builtin_amdgcn_fence(__ATOMIC_ACQUIRE, "agent");
            asm volatile("s_waitcnt vmcnt(0)" ::: "memory");
        }
        __builtin_amdgcn_s_barrier(); asm volatile("" ::: "memory");
    }
};

struct SplitOrder {
    StaticOrder P; int c, KS;
    __device__ void init(int N, int G_, int c_, int KS_) { P.init(TP, N, G_, c_); c = c_; KS = KS_; }
    __device__ bool next(int i, Unit& u) const {
        if (i == 0) return P.next(0, u);
        if (i > 1 || c >= 8 * KS) return false;
        const int tile = c / KS; u.pm = 64 + (tile & 1); u.pn = tile >> 1; u.ks = c - tile * KS; u.nt = 4; u.kb = u.ks * 512; return true;
    }
    __device__ __forceinline__ void a_ready(const Unit&) const {}
};
struct POrder {
    StaticOrder P;
    __device__ void init(int N, int G_, int c_) { P.init(TP, N, G_, c_); }
    __device__ bool next(int i, Unit& u) const { return i == 0 ? P.next(0, u) : false; }
    __device__ __forceinline__ void a_ready(const Unit&) const {}
};
struct SliceOrder {
    int j, KS;
    __device__ void init(int G_, int c_, int KS_) { KS = KS_; j = c_ - (G_ - 8 * KS_); }
    __device__ bool next(int i, Unit& u) const {
        if (i > 0 || j < 0) return false;
        const int tile = j / KS; u.pm = 64 + (tile & 1); u.pn = tile >> 1; u.ks = j - tile * KS; u.nt = (KS == 10 && u.ks >= 8) ? 6 : 4; u.kb = (KS == 10 && u.ks == 9) ? 38 * 128 : u.ks * 512; return true;
    }
    __device__ __forceinline__ void a_ready(const Unit&) const {}
};

template <class Epi, class Sched>
__device__ __forceinline__ void gemm_phase(LAS unsigned char* lds, const Gemm g, const Sched& S, const Epi& E) {
    int tid_ = threadIdx.x; asm volatile("" : "+v"(tid_));
    const int tid = tid_, wid = __builtin_amdgcn_readfirstlane(tid >> 6), lane = tid & 63, wr = wid >> 2, wc = wid & 3, fr = lane & 15, fq = lane >> 4;
    const int K = g.K, ntfull = K / BK;
    unsigned voffA[2], voffB[2];
#pragma unroll
    for (int i = 0; i < 2; ++i) { int R, C; stage_rc(tid * 16 + i * 8192, R, C); const int Rb = (R & ~31) + perm32(R & 31);
        voffA[i] = (unsigned)(R * K + C) * 2u; voffB[i] = (unsigned)(Rb * K + C) * 2u; }
    const size_t kstep = (size_t)(BK * 2);
    const size_t hstep = (size_t)HALF * K * 2;
    const size_t tstep = 2 * hstep;
    const unsigned ldsw = (unsigned)wid * 1024u;
    const int aoff = lds_byte(wr * 64 + fr, fq * 8), boff = lds_byte(wc * 32 + fr, fq * 8);
#define PG8_SA(b, h) (((b) * 2 + (h)) * HTB)
#define PG8_SB(b, h) ((4 + (b) * 2 + (h)) * HTB)
#define PG8_STAGE(bufoff, gbase, voff) do { _Pragma("unroll") for (int _i = 0; _i < 2; ++_i) \
        __builtin_amdgcn_global_load_lds((const unsigned*)((const char*)(gbase) + (voff)[_i]), (LAS unsigned*)(lds + (bufoff) + ldsw + _i * 8192), 16, 0, 0); } while (0)
#define PG8_LDA(dst, b, h) do { _Pragma("unroll") for (int m = 0; m < 4; ++m) _Pragma("unroll") for (int k = 0; k < 2; ++k) dst[m][k] = *(const LAS bf16x8*)(lds + PG8_SA(b, h) + aoff + m * 2048 + k * 1024); } while (0)
#define PG8_LDB(dst, b, h) do { _Pragma("unroll") for (int n = 0; n < 2; ++n) _Pragma("unroll") for (int k = 0; k < 2; ++k) dst[n][k] = *(const LAS bf16x8*)(lds + PG8_SB(b, h) + boff + n * 2048 + k * 1024); } while (0)
#define PG8_MMA(ai, bj, At, Bt) do { __builtin_amdgcn_s_setprio(1); _Pragma("unroll") for (int m = 0; m < 4; ++m) _Pragma("unroll") for (int n = 0; n < 2; ++n) _Pragma("unroll") for (int k = 0; k < 2; ++k) \
        acc[ai][bj][m][n] = __builtin_amdgcn_mfma_f32_16x16x32_bf16(Bt[n][k], At[m][k], acc[ai][bj][m][n], 0, 0, 0); __builtin_amdgcn_s_setprio(0); } while (0)
#define PG8_WAIT_V(n) asm volatile("s_waitcnt vmcnt(" #n ")" ::: "memory")
#define PG8_WAIT_L(n) asm volatile("s_waitcnt lgkmcnt(" #n ")" ::: "memory")
#define PG8_BAR __builtin_amdgcn_s_barrier()
#define PG8_SCHED __builtin_amdgcn_sched_barrier(0)
    Unit cur, nxt; int ui = 0;
    if (!S.next(0, cur)) return;
    S.a_ready(cur);
    f32x4 acc[2][2][4][2];
#pragma unroll
    for (int a = 0; a < 2; ++a)
#pragma unroll
        for (int b = 0; b < 2; ++b)
#pragma unroll
            for (int m = 0; m < 4; ++m)
#pragma unroll
                for (int n = 0; n < 2; ++n) acc[a][b][m][n] = (f32x4){0.f, 0.f, 0.f, 0.f};
    bf16x8 At[4][2], B0[2][2], B1[2][2];
    const char* cA = (const char*)g.A + (size_t)cur.pm * tstep + cur.kb; const char* cB = (const char*)g.Bt + (size_t)cur.pn * tstep + cur.kb;
    PG8_STAGE(PG8_SB(0, 0), cB, voffB); PG8_STAGE(PG8_SB(0, 1), cB + hstep, voffB); PG8_STAGE(PG8_SA(0, 0), cA, voffA); PG8_STAGE(PG8_SA(0, 1), cA + hstep, voffA);
    if (wr == 1) PG8_BAR;
    PG8_WAIT_V(2); PG8_BAR;
    PG8_STAGE(PG8_SB(1, 0), cB + kstep, voffB); PG8_STAGE(PG8_SA(1, 0), cA + kstep, voffA); PG8_STAGE(PG8_SB(1, 1), cB + hstep + kstep, voffB);
    PG8_WAIT_V(6); PG8_BAR;
    for (;;) {
        const bool has_next = S.next(ui + 1, nxt);
        const char* nA = has_next ? (const char*)g.A + (size_t)nxt.pm * tstep + nxt.kb : cA; const char* nB = has_next ? (const char*)g.Bt + (size_t)nxt.pn * tstep + nxt.kb : cB;
        const int nt = cur.nt ? cur.nt : ntfull;
        for (int t = 0; t < nt; t += 2) {
            const bool last = (t == nt - 2);
            if (last && has_next) S.a_ready(nxt);
            const char* a1 = cA + (size_t)(t + 1) * kstep;
            const char* a2 = last ? nA : cA + (size_t)(t + 2) * kstep; const char* b2 = last ? nB : cB + (size_t)(t + 2) * kstep;
            const char* a3 = a2 + kstep; const char* b3 = b2 + kstep;
            if constexpr (Epi::HAS_MID) { if (t == 8 || t == 12) { E.mid(acc, cur, t, wr, wc, fr, fq); PG8_SCHED; } }
            PG8_LDB(B0, 0, 0); PG8_LDB(B1, 0, 1); PG8_SCHED; PG8_LDA(At, 0, 0); PG8_STAGE(PG8_SA(1, 1), a1 + hstep, voffA);
            PG8_WAIT_V(8); PG8_WAIT_L(0); PG8_BAR; PG8_MMA(0, 0, At, B0); PG8_MMA(0, 1, At, B1); PG8_BAR; PG8_SCHED;
            PG8_LDA(At, 0, 1); PG8_STAGE(PG8_SB(0, 0), b2, voffB); PG8_STAGE(PG8_SB(0, 1), b2 + hstep, voffB); PG8_STAGE(PG8_SA(0, 0), a2, voffA);
            PG8_WAIT_V(8); PG8_WAIT_L(0); PG8_BAR; PG8_MMA(1, 0, At, B0); PG8_MMA(1, 1, At, B1); PG8_BAR; PG8_SCHED;
            PG8_LDB(B0, 1, 0); PG8_LDB(B1, 1, 1); PG8_SCHED; PG8_LDA(At, 1, 0); PG8_STAGE(PG8_SA(0, 1), a2 + hstep, voffA);
            PG8_WAIT_V(8); PG8_WAIT_L(0); PG8_BAR; PG8_MMA(0, 0, At, B0); PG8_MMA(0, 1, At, B1); PG8_BAR; PG8_SCHED;
            PG8_LDA(At, 1, 1); PG8_STAGE(PG8_SB(1, 0), b3, voffB); PG8_STAGE(PG8_SB(1, 1), b3 + hstep, voffB); PG8_STAGE(PG8_SA(1, 0), a3, voffA);
            PG8_WAIT_V(8); PG8_WAIT_L(0); PG8_BAR; PG8_MMA(1, 0, At, B0); PG8_MMA(1, 1, At, B1); PG8_BAR; PG8_SCHED;
        }
        if (wr == 0) PG8_BAR;
        E(acc, cur, wr, wc, fr, fq, lds);
        if (!has_next) break;
#pragma unroll
        for (int a = 0; a < 2; ++a)
#pragma unroll
            for (int b = 0; b < 2; ++b)
#pragma unroll
                for (int m = 0; m < 4; ++m)
#pragma unroll
                    for (int n = 0; n < 2; ++n) acc[a][b][m][n] = (f32x4){0.f, 0.f, 0.f, 0.f};
        cur = nxt; cA = nA; cB = nB; ++ui;
        if (wr == 1) PG8_BAR;
    }
    PG8_WAIT_V(0);
    PG8_BAR;
#undef PG8_SA
#undef PG8_SB
#undef PG8_STAGE
#undef PG8_LDA
#undef PG8_LDB
#undef PG8_MMA
#undef PG8_WAIT_V
#undef PG8_WAIT_L
#undef PG8_BAR
#undef PG8_SCHED
}

typedef f32x4 Acc[2][2][4][2];


struct SplitK {
    float* slab; unsigned* cnt; int KS;
    __device__ __forceinline__ void exchange(const Acc& acc, const Unit& u, int wid, int lane) const {
        const int tile = (u.pm - 64) + 2 * u.pn;
        f32x4* dst = (f32x4*)slab + ((size_t)(tile * KS + u.ks) * 8 + wid) * 2048 + lane;
#pragma unroll
        for (int ai = 0; ai < 2; ++ai)
#pragma unroll
            for (int bj = 0; bj < 2; ++bj)
#pragma unroll
                for (int m = 0; m < 4; ++m)
#pragma unroll
                    for (int n = 0; n < 2; ++n) dst[(((ai * 2 + bj) * 4 + m) * 2 + n) * 64] = acc[ai][bj][m][n];
        asm volatile("s_waitcnt vmcnt(0)" ::: "memory");
        __builtin_amdgcn_s_barrier();
        if (wid == 0 && lane == 0) {
            __builtin_amdgcn_fence(__ATOMIC_RELEASE, "agent");
            asm volatile("s_waitcnt vmcnt(0)" ::: "memory");
            (void)__hip_atomic_fetch_add(cnt + tile, 1u, __ATOMIC_RELAXED, __HIP_MEMORY_SCOPE_AGENT);
            unsigned sp = 0;
            while (__hip_atomic_load(cnt + tile, __ATOMIC_RELAXED, __HIP_MEMORY_SCOPE_AGENT) < (unsigned)KS) { __builtin_amdgcn_s_sleep(2); if (++sp > (1u << 22)) break; }
            __builtin_amdgcn_fence(__ATOMIC_ACQUIRE, "agent");
            asm volatile("s_waitcnt vmcnt(0)" ::: "memory");
        }
        __builtin_amdgcn_s_barrier(); asm volatile("" ::: "memory");
    }
    template <int NS> __device__ __forceinline__ f32x4 sum(int tile, int wid, int lane, int q) const {
        const f32x4* p = (const f32x4*)slab + ((size_t)(tile * NS) * 8 + wid) * 2048 + q * 64 + lane;
        f32x4 v[NS];
#pragma unroll
        for (int i = 0; i < NS; ++i) v[i] = p[(size_t)i * 8 * 2048];
        f32x4 t = v[0];
#pragma unroll
        for (int i = 1; i < NS; ++i) t += v[i];
        return t;
    }
    template <int NS, int NQ> __device__ __forceinline__ void sumq(int tile, int wid, int lane, const int (&q)[NQ], f32x4 (&out)[NQ]) const {
        const f32x4* p = (const f32x4*)slab + ((size_t)(tile * NS) * 8 + wid) * 2048 + lane;
        f32x4 v[NQ][NS];
#pragma unroll
        for (int j = 0; j < NQ; ++j)
#pragma unroll
            for (int i = 0; i < NS; ++i) v[j][i] = p[(size_t)i * 8 * 2048 + q[j] * 64];
#pragma unroll
        for (int j = 0; j < NQ; ++j) { f32x4 t = v[j][0];
#pragma unroll
            for (int i = 1; i < NS; ++i) t += v[j][i];
            out[j] = t; }
    }
    __device__ __forceinline__ f32x4 part(int tile, int slice, int wid, int lane, int q) const {
        return *((const f32x4*)slab + ((size_t)(tile * KS + slice) * 8 + wid) * 2048 + q * 64 + lane);
    }
};

struct EpiSwiglu {
    static constexpr bool HAS_MID = false;
    const float* ssq; bf16_t* act;
    __device__ __forceinline__ void operator()(Acc& acc, const Unit& u, int wr, int wc, int fr, int fq, LAS unsigned char* lds) const {
        const int row0 = u.pm * BM + wr * 64 + fr, col = u.pn * 128 + wc * 32 + 8 * fq;
#pragma unroll
        for (int ai = 0; ai < 2; ++ai)
#pragma unroll
            for (int m = 0; m < 4; ++m) {
                const int row = row0 + ai * HALF + m * 16;
                const float rs = row_rstd(ssq, row);
                float o[8];
#pragma unroll
                for (int n = 0; n < 2; ++n)
#pragma unroll
                    for (int i = 0; i < 4; ++i) { const float gv = acc[ai][0][m][n][i] * rs, uv = acc[ai][1][m][n][i] * rs; o[4 * n + i] = gv * fast_sigmoid(gv) * uv; }
                u32x4 w; w.x = cvt_pk_bf16(o[0], o[1]); w.y = cvt_pk_bf16(o[2], o[3]); w.z = cvt_pk_bf16(o[4], o[5]); w.w = cvt_pk_bf16(o[6], o[7]);
                *(u32x4*)(act + (size_t)row * FF + col) = w;
                asm volatile("" ::: "memory");
            }
    }
};

struct EpiResid {
    static constexpr bool HAS_MID = false;
    float* x; bf16_t* xb; float* ssq_out; float scale; SplitK sk;
    __device__ __forceinline__ void group(const f32x4 (&v)[2][2], int row, int col0, int pn, int wc, int fq) const {
        float ss = 0.f;
#pragma unroll
        for (int bj = 0; bj < 2; ++bj) {
            bf16_t* pb = xb + (size_t)row * D + col0 + bj * HALF;
            const u32x4 xo = *(const u32x4*)pb;
            f32x4 a = (f32x4){bf_lo(xo.x), bf_hi(xo.x), bf_lo(xo.y), bf_hi(xo.y)}, b = (f32x4){bf_lo(xo.z), bf_hi(xo.z), bf_lo(xo.w), bf_hi(xo.w)};
            a += v[bj][0] * scale; b += v[bj][1] * scale;
            if (x) { float* p = x + (size_t)row * D + col0 + bj * HALF; *(f32x4*)p = a; *(f32x4*)(p + 4) = b; }
            else {
                ss += (a[0] * a[0] + a[1] * a[1]) + (a[2] * a[2] + a[3] * a[3]) + (b[0] * b[0] + b[1] * b[1]) + (b[2] * b[2] + b[3] * b[3]);
                u32x4 w; w.x = cvt_pk_bf16(a[0], a[1]); w.y = cvt_pk_bf16(a[2], a[3]); w.z = cvt_pk_bf16(b[0], b[1]); w.w = cvt_pk_bf16(b[2], b[3]);
                *(u32x4*)pb = w;
            }
        }
        if (x) return;
        ss += __shfl_xor(ss, 16); ss += __shfl_xor(ss, 32);
        if (fq == 0) ssq_out[(size_t)row * 16 + pn * 4 + wc] = ss;
    }
    __device__ __forceinline__ void operator()(Acc& acc, const Unit& u, int wr, int wc, int fr, int fq, LAS unsigned char* lds) const {
        const int row0 = u.pm * BM + wr * 64 + fr, col0 = u.pn * BM + wc * 32 + 8 * fq;
        if (u.ks >= 0) {
            const int wid = wr * 4 + wc, lane = fq * 16 + fr, tile = (u.pm - 64) + 2 * u.pn;
            sk.exchange(acc, u, wid, lane);
            if (sk.KS >= 10) {
                if (u.ks < 8) {
                    const int ai = u.ks >> 2, m = u.ks & 3;
                    f32x4 v[2][2];
#pragma unroll
                    for (int bj = 0; bj < 2; ++bj) { const int q0 = ((ai * 2 + bj) * 4 + m) * 2; const int qq[2] = {q0, q0 + 1};
                        if (sk.KS == 11) sk.sumq<11, 2>(tile, wid, lane, qq, v[bj]); else sk.sumq<10, 2>(tile, wid, lane, qq, v[bj]); }
                    group(v, row0 + ai * HALF + m * 16, col0, u.pn, wc, fq);
                }
            } else {
#pragma unroll
                for (int pp = 0; pp < 2; ++pp) {
                    const int pair = u.ks * 2 + pp, ai = pair >> 2, m = pair & 3;
                    const int q0 = (ai * 2 * 4 + m) * 2, q1 = ((ai * 2 + 1) * 4 + m) * 2; const int qq[4] = {q0, q0 + 1, q1, q1 + 1};
                    f32x4 t[4]; sk.sumq<4, 4>(tile, wid, lane, qq, t);
                    const f32x4 v[2][2] = {{t[0], t[1]}, {t[2], t[3]}};
                    group(v, row0 + ai * HALF + m * 16, col0, u.pn, wc, fq);
                }
            }
            return;
        }
#pragma unroll
        for (int ai = 0; ai < 2; ++ai)
#pragma unroll
            for (int m = 0; m < 4; ++m) {
                const f32x4 v[2][2] = {{acc[ai][0][m][0], acc[ai][0][m][1]}, {acc[ai][1][m][0], acc[ai][1][m][1]}};
                group(v, row0 + ai * HALF + m * 16, col0, u.pn, wc, fq);
                asm volatile("" ::: "memory");
            }
    }
};

struct EpiMix {
    static constexpr bool HAS_MID = false;
    const float* ssq; const float* qn; const float* kn; const float* gate_b;
    bf16_t *Q, *Kb, *Vb, *G; float *PU, *CIN, *CB;
    float* kout_p; float* vout_p; float* kout_s; float* vout_s;
    float* xprobe; bf16_t* VT;
    __device__ __forceinline__ void operator()(Acc& acc, const Unit& u, int wr, int wc, int fr, int fq, LAS unsigned char* lds) const {
        const int row0 = u.pm * BM + wr * 64 + fr, pn = u.pn;
        const bool tail = u.pm >= 62;
        if (pn < 4) {
            const bool isk = pn >= 2; const float* nw = isk ? kn : qn; const int head = (pn & 1) * 4 + wc;
            float wv[2][8];
#pragma unroll
            for (int bj = 0; bj < 2; ++bj)
#pragma unroll
                for (int j = 0; j < 8; ++j) wv[bj][j] = nw[32 * bj + 8 * fq + j];
            bf16_t* dst = isk ? Kb : Q;
#pragma unroll
            for (int ai = 0; ai < 2; ++ai)
#pragma unroll
                for (int m = 0; m < 4; ++m) {
                    const int row = row0 + ai * HALF + m * 16;
                    const float rs = row_rstd(ssq, row);
                    float v[2][8]; float ss = 0.f;
#pragma unroll
                    for (int bj = 0; bj < 2; ++bj)
#pragma unroll
                        for (int n = 0; n < 2; ++n)
#pragma unroll
                            for (int i = 0; i < 4; ++i) { const float q = acc[ai][bj][m][n][i] * rs; v[bj][4 * n + i] = q; ss += q * q; }
                    ss += __shfl_xor(ss, 16); ss += __shfl_xor(ss, 32);
                    const float hr = __builtin_amdgcn_rsqf(ss * (1.0f / 64.0f) + EPS);
#pragma unroll
                    for (int bj = 0; bj < 2; ++bj) {
#pragma unroll
                        for (int j = 0; j < 8; ++j) v[bj][j] = v[bj][j] * hr * wv[bj][j];
                        u32x4 w; w.x = cvt_pk_bf16(v[bj][0], v[bj][1]); w.y = cvt_pk_bf16(v[bj][2], v[bj][3]); w.z = cvt_pk_bf16(v[bj][4], v[bj][5]); w.w = cvt_pk_bf16(v[bj][6], v[bj][7]);
                        const int c = head * 64 + 32 * bj + 8 * fq;
                        *(u32x4*)(dst + (size_t)row * 512 + c) = w;
                        if (isk && tail) {
                            float* o = (row < TP ? kout_p + (size_t)(row - (TP - 512)) * 512 : kout_s + (size_t)(row - TP) * 512) + c;
                            *(f32x4*)o = (f32x4){v[bj][0], v[bj][1], v[bj][2], v[bj][3]}; *(f32x4*)(o + 4) = (f32x4){v[bj][4], v[bj][5], v[bj][6], v[bj][7]};
                        }
                    }
                    asm volatile("" ::: "memory");
                }
        } else if (pn == 7 || pn == 8) {
            const int c = (pn - 7) * 128 + wc * 32 + 8 * fq;
#pragma unroll
            for (int ai = 0; ai < 2; ++ai)
#pragma unroll
                for (int m = 0; m < 4; ++m) {
                    const int row = row0 + ai * HALF + m * 16;
                    const float rs = row_rstd(ssq, row), rs2 = rs * rs;
                    float* o = CIN + (size_t)row * 256 + c;
                    *(f32x4*)o = acc[ai][0][m][0] * acc[ai][1][m][0] * rs2; *(f32x4*)(o + 4) = acc[ai][0][m][1] * acc[ai][1][m][1] * rs2;
                    asm volatile("" ::: "memory");
                }
        } else if (pn < 10) {
            const int cl = wc * 32 + 8 * fq;
#pragma unroll
            for (int ai = 0; ai < 2; ++ai)
#pragma unroll
                for (int m = 0; m < 4; ++m) {
                    const int row = row0 + ai * HALF + m * 16;
                    const float rs = row_rstd(ssq, row);
#pragma unroll
                    for (int bj = 0; bj < 2; ++bj) {
                        const f32x4 a = acc[ai][bj][m][0] * rs, b = acc[ai][bj][m][1] * rs;
                        const int c = bj * HALF + cl;
                        if (pn < 6) {
                            const int cv = (pn - 4) * 256 + c;
                            u32x4 w; w.x = cvt_pk_bf16(a[0], a[1]); w.y = cvt_pk_bf16(a[2], a[3]); w.z = cvt_pk_bf16(b[0], b[1]); w.w = cvt_pk_bf16(b[2], b[3]);
                            *(u32x4*)(Vb + (size_t)row * 512 + cv) = w;
                            if (tail) { float* o = (row < TP ? vout_p + (size_t)(row - (TP - 512)) * 512 : vout_s + (size_t)(row - TP) * 512) + cv; *(f32x4*)o = a; *(f32x4*)(o + 4) = b; }
                        } else {
                            float* o = (pn == 6 ? PU : CB) + (size_t)row * 256 + c; *(f32x4*)o = a; *(f32x4*)(o + 4) = b;
                        }
                    }
                    asm volatile("" ::: "memory");
                }
        } else {
            const int cg0 = (pn - 10) * 256 + wc * 32 + 8 * fq;
            f32x4 gb[2][2];
#pragma unroll
            for (int bj = 0; bj < 2; ++bj)
#pragma unroll
                for (int n = 0; n < 2; ++n) gb[bj][n] = *(const f32x4*)(gate_b + cg0 + bj * HALF + 4 * n);
#pragma unroll
            for (int ai = 0; ai < 2; ++ai)
#pragma unroll
                for (int m = 0; m < 4; ++m) {
                    const int row = row0 + ai * HALF + m * 16;
                    const float rs = row_rstd(ssq, row);
#pragma unroll
                    for (int bj = 0; bj < 2; ++bj) {
                        const f32x4 a = acc[ai][bj][m][0] * rs + gb[bj][0], b = acc[ai][bj][m][1] * rs + gb[bj][1];
                        u32x4 w; w.x = cvt_pk_bf16(fast_sigmoid(a[0]), fast_sigmoid(a[1])); w.y = cvt_pk_bf16(fast_sigmoid(a[2]), fast_sigmoid(a[3]));
                        w.z = cvt_pk_bf16(fast_sigmoid(b[0]), fast_sigmoid(b[1])); w.w = cvt_pk_bf16(fast_sigmoid(b[2]), fast_sigmoid(b[3]));
                        *(u32x4*)(G + (size_t)row * 3072 + cg0 + bj * HALF) = w;
                        if (PROBE_G && pn >= 18) { float* xo = xprobe + (size_t)row * D + cg0 - 2048 + bj * HALF; *(f32x4*)xo = (f32x4){bf_lo(w.x), bf_hi(w.x), bf_lo(w.y), bf_hi(w.y)}; *(f32x4*)(xo + 4) = (f32x4){bf_lo(w.z), bf_hi(w.z), bf_lo(w.w), bf_hi(w.w)}; }
                    }
                    asm volatile("" ::: "memory");
                }
        }
    }
};

struct EpiBranch {
    static constexpr bool HAS_MID = !PROBE_NOG;
    const bf16_t* G; bf16_t* MB; float* xprobe; SplitK sk;
    __device__ __forceinline__ void mid(Acc& acc, const Unit& u, int t, int wr, int wc, int fr, int fq) const {
        asm volatile("" : "+v"(fr), "+v"(fq));
        const int row0 = u.pm * BM + wr * 64 + fr, col0 = u.pn * BM + wc * 32 + 8 * fq + (t == 8 ? 0 : 1024);
#pragma unroll
        for (int ai = 0; ai < 2; ++ai)
#pragma unroll
            for (int m = 0; m < 4; ++m) {
                const bf16_t* gp = G + (size_t)(row0 + ai * HALF + m * 16) * 3072 + col0;
#pragma unroll
                for (int bj = 0; bj < 2; ++bj) {
                    const u32x4 ga = *(const u32x4*)(gp + bj * HALF), gb = *(const u32x4*)(gp + bj * HALF + 1024);
                    f32x4 r0, r1;
                    r0[0] = bf_lo(ga.x) * __builtin_amdgcn_rcpf(bf_lo(gb.x)); r0[1] = bf_hi(ga.x) * __builtin_amdgcn_rcpf(bf_hi(gb.x));
                    r0[2] = bf_lo(ga.y) * __builtin_amdgcn_rcpf(bf_lo(gb.y)); r0[3] = bf_hi(ga.y) * __builtin_amdgcn_rcpf(bf_hi(gb.y));
                    r1[0] = bf_lo(ga.z) * __builtin_amdgcn_rcpf(bf_lo(gb.z)); r1[1] = bf_hi(ga.z) * __builtin_amdgcn_rcpf(bf_hi(gb.z));
                    r1[2] = bf_lo(ga.w) * __builtin_amdgcn_rcpf(bf_lo(gb.w)); r1[3] = bf_hi(ga.w) * __builtin_amdgcn_rcpf(bf_hi(gb.w));
                    acc[ai][bj][m][0] *= r0; acc[ai][bj][m][1] *= r1;
                }
                asm volatile("" ::: "memory");
            }
    }
    __device__ __forceinline__ void operator()(Acc& acc, const Unit& u, int wr, int wc, int fr, int fq, LAS unsigned char* lds) const {
        const int row0 = u.pm * BM + wr * 64 + fr, col0 = u.pn * BM + wc * 32 + 8 * fq;
        if (u.ks >= 0) {
            const int wid = wr * 4 + wc, lane = fq * 16 + fr, tile = (u.pm - 64) + 2 * u.pn;
            sk.exchange(acc, u, wid, lane);
#pragma unroll
            for (int pp = 0; pp < 2; ++pp) {
                const int pair = u.ks * 2 + pp, ai = pair >> 2, m = pair & 3, row = row0 + ai * HALF + m * 16;
                const bf16_t* gp = G + (size_t)row * 3072 + col0;
#pragma unroll
                for (int bj = 0; bj < 2; ++bj) {
                    const u32x4 g0 = *(const u32x4*)(gp + bj * HALF), g1 = *(const u32x4*)(gp + bj * HALF + 1024), g2 = *(const u32x4*)(gp + bj * HALF + 2048);
                    const int q0 = ((ai * 2 + bj) * 4 + m) * 2;
                    const f32x4 a0 = sk.part(tile, 0, wid, lane, q0) + sk.part(tile, 1, wid, lane, q0), a1 = sk.part(tile, 2, wid, lane, q0), a2 = sk.part(tile, 3, wid, lane, q0);
                    const f32x4 b0 = sk.part(tile, 0, wid, lane, q0 + 1) + sk.part(tile, 1, wid, lane, q0 + 1), b1 = sk.part(tile, 2, wid, lane, q0 + 1), b2 = sk.part(tile, 3, wid, lane, q0 + 1);
                    u32x4 w;
                    w.x = cvt_pk_bf16(bf_lo(g0.x) * a0[0] + bf_lo(g1.x) * a1[0] + bf_lo(g2.x) * a2[0], bf_hi(g0.x) * a0[1] + bf_hi(g1.x) * a1[1] + bf_hi(g2.x) * a2[1]);
                    w.y = cvt_pk_bf16(bf_lo(g0.y) * a0[2] + bf_lo(g1.y) * a1[2] + bf_lo(g2.y) * a2[2], bf_hi(g0.y) * a0[3] + bf_hi(g1.y) * a1[3] + bf_hi(g2.y) * a2[3]);
                    w.z = cvt_pk_bf16(bf_lo(g0.z) * b0[0] + bf_lo(g1.z) * b1[0] + bf_lo(g2.z) * b2[0], bf_hi(g0.z) * b0[1] + bf_hi(g1.z) * b1[1] + bf_hi(g2.z) * b2[1]);
                    w.w = cvt_pk_bf16(bf_lo(g0.w) * b0[2] + bf_lo(g1.w) * b1[2] + bf_lo(g2.w) * b2[2], bf_hi(g0.w) * b0[3] + bf_hi(g1.w) * b1[3] + bf_hi(g2.w) * b2[3]);
                    *(u32x4*)(MB + (size_t)row * D + col0 + bj * HALF) = w;
                }
            }
            return;
        }
#pragma unroll
        for (int ai = 0; ai < 2; ++ai)
#pragma unroll
            for (int m = 0; m < 4; ++m) {
                const int row = row0 + ai * HALF + m * 16;
#pragma unroll
                for (int bj = 0; bj < 2; ++bj) {
                    u32x4 gc = *(const u32x4*)(G + (size_t)row * 3072 + 2048 + col0 + bj * HALF); if (PROBE_NOG) gc = (u32x4){0x3f803f80u, 0x3f803f80u, 0x3f803f80u, 0x3f803f80u};
                    const f32x4 a = acc[ai][bj][m][0], b = acc[ai][bj][m][1];
                    u32x4 w; w.x = cvt_pk_bf16(a[0] * bf_lo(gc.x), a[1] * bf_hi(gc.x)); w.y = cvt_pk_bf16(a[2] * bf_lo(gc.y), a[3] * bf_hi(gc.y));
                    w.z = cvt_pk_bf16(b[0] * bf_lo(gc.z), b[1] * bf_hi(gc.z)); w.w = cvt_pk_bf16(b[2] * bf_lo(gc.w), b[3] * bf_hi(gc.w));
                    *(u32x4*)(MB + (size_t)row * D + col0 + bj * HALF) = w;
                    if (PROBE_M) { float* xo = xprobe + (size_t)row * D + col0 + bj * HALF; *(f32x4*)xo = (f32x4){a[0] * bf_lo(gc.x), a[1] * bf_hi(gc.x), a[2] * bf_lo(gc.y), a[3] * bf_hi(gc.y)}; *(f32x4*)(xo + 4) = (f32x4){b[0] * bf_lo(gc.z), b[1] * bf_hi(gc.z), b[2] * bf_lo(gc.w), b[3] * bf_hi(gc.w)}; }
                }
                asm volatile("" ::: "memory");
            }
    }
};
}

__device__ __forceinline__ float wave_sum(float v) {
#pragma unroll
    for (int o = 1; o < 64; o <<= 1) v += __shfl_xor(v, o);
    return v;
}
__device__ __forceinline__ void tr_item(const float* W, int ldw, int k0s, int c0s, const float* ksc, bf16_t* WT, int ldt, int r0d, int k0d, LAS float* scr, int lane) {
    f32x4 ld[8];
#pragma unroll
    for (int i = 0; i < 8; ++i) ld[i] = *(const f32x4*)(W + (size_t)(k0s + 8 * i + (lane >> 3)) * ldw + c0s + 4 * (lane & 7));
#pragma unroll
    for (int i = 0; i < 8; ++i) { const int kk = 8 * i + (lane >> 3); f32x4 v = ld[i]; if (ksc) v *= ksc[k0s + kk];
        LAS float* d = scr + kk * 33 + 4 * (lane & 7); d[0] = v[0]; d[1] = v[1]; d[2] = v[2]; d[3] = v[3]; }
    asm volatile("s_waitcnt lgkmcnt(0)" ::: "memory");
    const int c = lane & 7;
#pragma unroll
    for (int j = 0; j < 4; ++j) { const int n = (lane >> 3) + 8 * j; const LAS float* s = scr + (8 * c) * 33 + n;
        u32x4 o; o.x = cvt_pk_bf16(s[0 * 33], s[1 * 33]); o.y = cvt_pk_bf16(s[2 * 33], s[3 * 33]); o.z = cvt_pk_bf16(s[4 * 33], s[5 * 33]); o.w = cvt_pk_bf16(s[6 * 33], s[7 * 33]);
        *(u32x4*)(WT + (size_t)(r0d + n) * ldt + k0d + 8 * c) = o; }
    asm volatile("s_waitcnt lgkmcnt(0)" ::: "memory");
}
__device__ __forceinline__ void fold_pool_item(const float* pw, const float* psc, const float* Wp, int c0, bf16_t* WT, int k0d, LAS float* scr, int lane) {
    const int n = lane & 31, hf = lane >> 5;
    float wp[64];
#pragma unroll
    for (int e = 0; e < 64; ++e) wp[e] = Wp[(size_t)e * D + c0 + n] * psc[e];
    for (int cc = hf * 32; cc < hf * 32 + 32; ++cc) {
        const f32x4* pr = (const f32x4*)(pw + cc * 64); float acc = 0.f;
#pragma unroll
        for (int q = 0; q < 16; ++q) { const f32x4 p4 = pr[q]; acc += p4[0] * wp[4 * q] + p4[1] * wp[4 * q + 1] + p4[2] * wp[4 * q + 2] + p4[3] * wp[4 * q + 3]; }
        scr[cc * 33 + n] = acc;
    }
    asm volatile("s_waitcnt lgkmcnt(0)" ::: "memory");
    const int c = lane & 7;
#pragma unroll
    for (int j = 0; j < 4; ++j) { const int nn = (lane >> 3) + 8 * j; const LAS float* sx = scr + (8 * c) * 33 + nn;
        u32x4 o; o.x = cvt_pk_bf16(sx[0 * 33], sx[1 * 33]); o.y = cvt_pk_bf16(sx[2 * 33], sx[3 * 33]); o.z = cvt_pk_bf16(sx[4 * 33], sx[5 * 33]); o.w = cvt_pk_bf16(sx[6 * 33], sx[7 * 33]);
        *(u32x4*)(WT + (size_t)(c0 + nn) * D + k0d + 8 * c) = o; }
    asm volatile("s_waitcnt lgkmcnt(0)" ::: "memory");
}
__device__ __forceinline__ int mixcol(int c) {
    const int pn = c >> 8, cc = c & 255, bj = cc >> 7, wc = (cc >> 5) & 3;
    if (pn < 4) return pn * 256 + wc * 64 + bj * 32;
    if (pn == 7 || pn == 8) return (bj ? 2304 : 1792) + (pn - 7) * 128 + (cc & 127);
    if (pn == 9) return 2048 + cc;
    return c;
}
__device__ __forceinline__ void prologue(const Args& a, LAS unsigned char* lds, int bid, int gdim) {
    int tid_ = threadIdx.x; asm volatile("" : "+v"(tid_));
    const int tid = tid_, lane = tid & 63, wave = tid >> 6;
    LAS float* scr = (LAS float*)(lds + wave * 16384);
    const int gw = bid * 8 + wave, NGW = gdim * 8;
    constexpr int PER_LAYER = 12288;
    for (int it = gw; it < DEPTH * PER_LAYER; it += NGW) {
        const int l = it / PER_LAYER; int r = it % PER_LAYER;
        bf16_t* WL = (bf16_t*)(a.ws + WS_W) + (size_t)l * LAYER_W_ELEMS;
        if (r < 2816) { const int kb = r / 176, c = (r % 176) * 32; const int src = ((c >> 7) & 1) * FF + (c >> 8) * 128 + (c & 127);
            tr_item(a.in[7] + (size_t)l * D * NIN, NIN, kb * 64, src, a.in[6] + l * D, WL + W_1IN, D, c, kb * 64, scr, lane); continue; }
        r -= 2816;
        if (r < 1408) { const int kb = r / 32, c = (r % 32) * 32; tr_item(a.in[8] + (size_t)l * FF * D, D, kb * 64, c, nullptr, WL + W_1OUT, FF, c, kb * 64, scr, lane); continue; }
        r -= 1408;
        if (r < 2816) { const int kb = r / 176, c = (r % 176) * 32; tr_item(a.in[10] + (size_t)l * D * NIN, NIN, kb * 64, mixcol(c), a.in[9] + l * D, WL + W_MIX, D, c, kb * 64, scr, lane); continue; }
        r -= 2816;
        if (r < 512) {
            if (r < 256) { const int kb = r / 32, c = (r % 32) * 32; tr_item(a.in[19] + (size_t)l * 512 * D, D, kb * 64, c, nullptr, WL + W_BR, D, c, kb * 64, scr, lane); }
            else if (r < 384) { r -= 256; fold_pool_item(a.in[15] + (size_t)(l * 4 + r / 32) * 4096, a.in[16] + l * 256 + (r / 32) * 64, a.in[20] + (size_t)l * 256 * D + (size_t)(r / 32) * 64 * D, (r % 32) * 32, WL + W_BR, 512 + (r / 32) * 64, scr, lane); }
            else { r -= 384; const int kb = r / 32, c = (r % 32) * 32; tr_item(a.in[21] + (size_t)l * 256 * D, D, kb * 64, c, nullptr, WL + W_BR, D, c, 768 + kb * 64, scr, lane); }
            continue; }
        r -= 512;
        if (r < 512) { const int kb = r / 32, c = (r % 32) * 32; tr_item(a.in[22] + (size_t)l * D * D, D, kb * 64, c, nullptr, WL + W_O, D, c, kb * 64, scr, lane); continue; }
        r -= 512;
        if (r < 2816) { const int kb = r / 176, c = (r % 176) * 32; const int src = ((c >> 7) & 1) * FF + (c >> 8) * 128 + (c & 127);
            tr_item(a.in[24] + (size_t)l * D * NIN, NIN, kb * 64, src, a.in[23] + l * D, WL + W_2IN, D, c, kb * 64, scr, lane); continue; }
        r -= 2816;
        { const int kb = r / 32, c = (r % 32) * 32; tr_item(a.in[25] + (size_t)l * FF * D, D, kb * 64, c, nullptr, WL + W_2OUT, FF, c, kb * 64, scr, lane); }
    }
    float* ssq = (float*)(a.ws + WS_SSQ); bf16_t* XB = (bf16_t*)(a.ws + WS_XB);
    for (int row = gw; row < T; row += NGW) {
        const float* src = row < TP ? a.in[0] + (size_t)row * D : a.in[1] + (size_t)(row - TP) * D;
        float s = 0.f;
#pragma unroll
        for (int j = 0; j < 4; ++j) { const f32x4 v = *(const f32x4*)(src + 4 * lane + 256 * j); s += (v[0] * v[0] + v[1] * v[1]) + (v[2] * v[2] + v[3] * v[3]);
            u32x2 w; w.x = cvt_pk_bf16(v[0], v[1]); w.y = cvt_pk_bf16(v[2], v[3]); *(u32x2*)(XB + (size_t)row * D + 4 * lane + 256 * j) = w; }
        s = wave_sum(s);
        if (lane < 16) ssq[(size_t)row * 16 + lane] = lane == 0 ? s : 0.f;
    }
}

#define LDS_SYNC() do { asm volatile("s_waitcnt lgkmcnt(0)" ::: "memory"); __builtin_amdgcn_s_barrier(); asm volatile("" ::: "memory"); } while (0)
constexpr int KS_STRIDE = 72, VT_STRIDE = 68;
constexpr int ATT_KS = 0, ATT_VT = 2 * 64 * KS_STRIDE * 2, ATT_BIAS = ATT_VT + 2 * 64 * VT_STRIDE * 2;

template <bool SAMPLE>
__device__ __forceinline__ void attn_unit(const Args& a, LAS unsigned char* lds, int l, int ux) {
    int tid_ = threadIdx.x; asm volatile("" : "+v"(tid_));
    const int tid = tid_, lane = tid & 63, wave = __builtin_amdgcn_readfirstlane(tid >> 6), hl = wave >> 2, qb = wave & 3, fr = lane & 15, fq = lane >> 4;
    const bf16_t* Q = (const bf16_t*)(a.ws + WS_Q); const bf16_t* Kb = (const bf16_t*)(a.ws + WS_K); const bf16_t* Vb = (const bf16_t*)(a.ws + WS_V);
    bf16_t* OC = (bf16_t*)(a.ws + WS_OC);
    const int hp = ux & 3, cb = ux >> 2;
    const int qrow0 = SAMPLE ? TP + cb * SL : cb * 64;
    const int first = SAMPLE ? 0 : (cb < 8 ? 8 - cb : 0);
    const bool active = SAMPLE ? (qb == 0) : true;
    const int h = hp * 2 + hl;
    LAS bf16_t* Ks = (LAS bf16_t*)(lds + ATT_KS); LAS bf16_t* Vt = (LAS bf16_t*)(lds + ATT_VT); LAS float* Bs = (LAS float*)(lds + ATT_BIAS);
    const float* ck = a.in[2] + ((size_t)(l * NBATCH + cb) * RC) * 512; const float* cv = a.in[3] + ((size_t)(l * NBATCH + cb) * RC) * 512;

    LDS_SYNC();
    for (int i = tid; i < 514; i += 512) { const int hh = i / 257, j = i % 257; Bs[hh * 260 + j] = a.in[14][(size_t)(l * 8 + hp * 2 + hh) * 257 + j]; }
    bf16x8 qf[2];
    if (active) {
        const bf16_t* qp = Q + (size_t)(qrow0 + qb * 16 + fr) * 512 + h * 64 + 8 * fq;
        qf[0] = *(const bf16x8*)qp; qf[1] = *(const bf16x8*)(qp + 32);
    }
    f32x4 o[4]; float mrun = -1e30f, lrun = 0.f;
#pragma unroll
    for (int i = 0; i < 4; ++i) o[i] = (f32x4){0.f, 0.f, 0.f, 0.f};

    u32x4 kr[2], vr[2]; f32x4 kf[2][2], vf[2][2];
    auto issue = [&](int ti) {
        if (SAMPLE && ti < 8) {
#pragma unroll
            for (int p = 0; p < 2; ++p) {
                const int idx = tid + p * 512, key = idx >> 4, seg = idx & 15;
                const float* s = ck + (size_t)(ti * 64 + key) * 512 + hp * 128 + seg * 8; kf[p][0] = *(const f32x4*)s; kf[p][1] = *(const f32x4*)(s + 4);
                const int sv = wave + 8 * p; const float* s2 = cv + (size_t)(ti * 64 + lane) * 512 + hp * 128 + sv * 8; vf[p][0] = *(const f32x4*)s2; vf[p][1] = *(const f32x4*)(s2 + 4);
            }
        } else {
            const int tok0 = SAMPLE ? qrow0 : (cb - 8 + ti) * 64;
#pragma unroll
            for (int p = 0; p < 2; ++p) {
                const int idx = tid + p * 512, key = idx >> 4, seg = idx & 15;
                const bool okk = !SAMPLE || key < SL, okv = !SAMPLE || lane < SL;
                kr[p] = okk ? *(const u32x4*)(Kb + (size_t)(tok0 + key) * 512 + hp * 128 + seg * 8) : (u32x4){0u, 0u, 0u, 0u};
                const int sv = wave + 8 * p;
                vr[p] = okv ? *(const u32x4*)(Vb + (size_t)(tok0 + lane) * 512 + hp * 128 + sv * 8) : (u32x4){0u, 0u, 0u, 0u};
            }
        }
    };
    auto commit = [&](int ti) {
        if (SAMPLE && ti < 8) {
#pragma unroll
            for (int p = 0; p < 2; ++p) {
                kr[p].x = cvt_pk_bf16(kf[p][0][0], kf[p][0][1]); kr[p].y = cvt_pk_bf16(kf[p][0][2], kf[p][0][3]); kr[p].z = cvt_pk_bf16(kf[p][1][0], kf[p][1][1]); kr[p].w = cvt_pk_bf16(kf[p][1][2], kf[p][1][3]);
                vr[p].x = cvt_pk_bf16(vf[p][0][0], vf[p][0][1]); vr[p].y = cvt_pk_bf16(vf[p][0][2], vf[p][0][3]); vr[p].z = cvt_pk_bf16(vf[p][1][0], vf[p][1][1]); vr[p].w = cvt_pk_bf16(vf[p][1][2], vf[p][1][3]);
            }
        }
#pragma unroll
        for (int p = 0; p < 2; ++p) {
            const int idx = tid + p * 512, key = idx >> 4, seg = idx & 15;
            *(LAS u32x4*)(Ks + ((seg >> 3) * 64 + key) * KS_STRIDE + (seg & 7) * 8) = kr[p];
            const int sv = wave + 8 * p; LAS bf16_t* vp = Vt + ((sv >> 3) * 64 + (sv & 7) * 8) * VT_STRIDE + lane;
            vp[0 * VT_STRIDE] = (bf16_t)(vr[p].x & 0xffffu); vp[1 * VT_STRIDE] = (bf16_t)(vr[p].x >> 16);
            vp[2 * VT_STRIDE] = (bf16_t)(vr[p].y & 0xffffu); vp[3 * VT_STRIDE] = (bf16_t)(vr[p].y >> 16);
            vp[4 * VT_STRIDE] = (bf16_t)(vr[p].z & 0xffffu); vp[5 * VT_STRIDE] = (bf16_t)(vr[p].z >> 16);
            vp[6 * VT_STRIDE] = (bf16_t)(vr[p].w & 0xffffu); vp[7 * VT_STRIDE] = (bf16_t)(vr[p].w >> 16);
        }
    };

    issue(first);
    for (int ti = first; ti <= 8; ++ti) {
        commit(ti);
        LDS_SYNC();
        if (ti < 8) issue(ti + 1);
        if (active) {
            f32x4 s[4];
#pragma unroll
            for (int kt = 0; kt < 4; ++kt) {
                s[kt] = (f32x4){0.f, 0.f, 0.f, 0.f};
#pragma unroll
                for (int ks = 0; ks < 2; ++ks) {
                    const bf16x8 ka = *(const LAS bf16x8*)(Ks + (hl * 64 + kt * 16 + fr) * KS_STRIDE + ks * 32 + 8 * fq);
                    s[kt] = __builtin_amdgcn_mfma_f32_16x16x32_bf16(ka, qf[ks], s[kt], 0, 0, 0);
                }
            }
            const int qoff = qb * 16 + fr; float mx = -1e30f;
            if (ti >= 6) {
#pragma unroll
                for (int kt = 0; kt < 4; ++kt)
#pragma unroll
                    for (int i = 0; i < 4; ++i) {
                        const int kk = kt * 16 + 4 * fq + i; int rel = (ti - 8) * 64 + kk - qoff; rel = rel < -128 ? -128 : (rel > 128 ? 128 : rel);
                        float v = s[kt][i] * 0.125f + Bs[hl * 260 + rel + 128];
                        if (SAMPLE && ti == 8 && kk >= SL) v = -1e30f;
                        s[kt][i] = v; mx = fmaxf(mx, v);
                    }
            } else {
                const float b0 = Bs[hl * 260];
#pragma unroll
                for (int kt = 0; kt < 4; ++kt)
#pragma unroll
                    for (int i = 0; i < 4; ++i) { const float v = s[kt][i] * 0.125f + b0; s[kt][i] = v; mx = fmaxf(mx, v); }
            }
            mx = fmaxf(mx, __shfl_xor(mx, 16)); mx = fmaxf(mx, __shfl_xor(mx, 32));
            const float mnew = fmaxf(mrun, mx), alpha = __expf(mrun - mnew); mrun = mnew;
            float ps = 0.f;
#pragma unroll
            for (int kt = 0; kt < 4; ++kt)
#pragma unroll
                for (int i = 0; i < 4; ++i) { const float p = __expf(s[kt][i] - mnew); s[kt][i] = p; ps += p; }
            lrun = lrun * alpha + ps;
#pragma unroll
            for (int db = 0; db < 4; ++db) o[db] *= alpha;
            bf16x8 pb[2];
#pragma unroll
            for (int kp = 0; kp < 2; ++kp) {
                u32x4 w; w.x = cvt_pk_bf16(s[2 * kp][0], s[2 * kp][1]); w.y = cvt_pk_bf16(s[2 * kp][2], s[2 * kp][3]);
                w.z = cvt_pk_bf16(s[2 * kp + 1][0], s[2 * kp + 1][1]); w.w = cvt_pk_bf16(s[2 * kp + 1][2], s[2 * kp + 1][3]);
                pb[kp] = __builtin_bit_cast(bf16x8, w);
            }
#pragma unroll
            for (int db = 0; db < 4; ++db)
#pragma unroll
                for (int kp = 0; kp < 2; ++kp) {
                    const LAS bf16_t* vp = Vt + (hl * 64 + db * 16 + fr) * VT_STRIDE + kp * 32 + 4 * fq;
                    const u32x2 v0 = *(const LAS u32x2*)vp, v1 = *(const LAS u32x2*)(vp + 16);
                    u32x4 w; w.x = v0.x; w.y = v0.y; w.z = v1.x; w.w = v1.y;
                    o[db] = __builtin_amdgcn_mfma_f32_16x16x32_bf16(__builtin_bit_cast(bf16x8, w), pb[kp], o[db], 0, 0, 0);
                }
        }
        LDS_SYNC();
    }
    if (active) {
        lrun += __shfl_xor(lrun, 16); lrun += __shfl_xor(lrun, 32);
        const float inv = 1.0f / lrun;
        bf16_t* op = OC + (size_t)(qrow0 + qb * 16 + fr) * D + h * 64 + 4 * fq;
#pragma unroll
        for (int db = 0; db < 4; ++db) { u32x2 w; w.x = cvt_pk_bf16(o[db][0] * inv, o[db][1] * inv); w.y = cvt_pk_bf16(o[db][2] * inv, o[db][3] * inv); *(u32x2*)(op + db * 16) = w; }
    }
}


template <int DB> __device__ __forceinline__ void tr_read4(unsigned addr, u32x2& r0, u32x2& r1, u32x2& r2, u32x2& r3) {
    asm volatile("ds_read_b64_tr_b16 %0, %4 offset:%5\n\tds_read_b64_tr_b16 %1, %4 offset:%6\n\tds_read_b64_tr_b16 %2, %4 offset:%7\n\tds_read_b64_tr_b16 %3, %4 offset:%8\n\ts_waitcnt lgkmcnt(0)"
                 : "=&v"(r0), "=&v"(r1), "=&v"(r2), "=&v"(r3)
                 : "v"(addr), "n"(DB * 32), "n"(DB * 32 + 16 * 144), "n"(DB * 32 + 32 * 144), "n"(DB * 32 + 48 * 144) : "memory");
}

constexpr int PKV_STRIDE = 72, PBUF_BYTES = 2 * (2 * 64 * PKV_STRIDE * 2), PATT_BIAS = 2 * PBUF_BYTES;
__device__ __forceinline__ void attn_unit_p(const Args& a, LAS unsigned char* lds, int l, int ux) {
    int tid_ = threadIdx.x; asm volatile("" : "+v"(tid_));
    const int tid = tid_, lane = tid & 63, wave = __builtin_amdgcn_readfirstlane(tid >> 6), hl = wave >> 2, qb = wave & 3, fr = lane & 15, fq = lane >> 4;
    const bf16_t* Q = (const bf16_t*)(a.ws + WS_Q); const bf16_t* Kb = (const bf16_t*)(a.ws + WS_K); const bf16_t* Vb = (const bf16_t*)(a.ws + WS_V);
    bf16_t* OC = (bf16_t*)(a.ws + WS_OC);
    const int hp = ux & 3, cb = ux >> 2, qrow0 = cb * 64, first = cb < 8 ? 8 - cb : 0, h = hp * 2 + hl;
    LAS float* Bs = (LAS float*)(lds + PATT_BIAS);
    LDS_SYNC();
    for (int i = tid; i < 514; i += 512) { const int hh = i / 257, j = i % 257; Bs[hh * 260 + j] = a.in[14][(size_t)(l * 8 + hp * 2 + hh) * 257 + j]; }
    bf16x8 qf[2];
    { const bf16_t* qp = Q + (size_t)(qrow0 + qb * 16 + fr) * 512 + h * 64 + 8 * fq; qf[0] = *(const bf16x8*)qp; qf[1] = *(const bf16x8*)(qp + 32); }
    f32x4 o[4]; float mrun = -1e30f, lrun = 0.f;
#pragma unroll
    for (int i = 0; i < 4; ++i) o[i] = (f32x4){0.f, 0.f, 0.f, 0.f};
    u32x4 kr[2], vr[2];
#define PA_ISSUE(ti) do { const int cix_ = cb - 8 + (ti); _Pragma("unroll") for (int p = 0; p < 2; ++p) { const int idx = tid + p * 512; \
        kr[p] = *(const u32x4*)(Kb + (size_t)(cix_ * 64 + (idx >> 4)) * 512 + hp * 128 + (idx & 15) * 8); \
        vr[p] = *(const u32x4*)(Vb + (size_t)(cix_ * 64 + (idx >> 4)) * 512 + hp * 128 + (idx & 15) * 8); } } while (0)
#define PA_COMMIT(bufb) do { LAS bf16_t* Ks_ = (LAS bf16_t*)(lds + (bufb) * PBUF_BYTES); LAS bf16_t* Vt_ = Ks_ + 2 * 64 * PKV_STRIDE; \
        _Pragma("unroll") for (int p = 0; p < 2; ++p) { const int idx = tid + p * 512; \
        *(LAS u32x4*)(Ks_ + (((idx & 15) >> 3) * 64 + (idx >> 4)) * PKV_STRIDE + (idx & 7) * 8) = kr[p]; \
        *(LAS u32x4*)(Vt_ + (((idx & 15) >> 3) * 64 + (idx >> 4)) * PKV_STRIDE + (idx & 7) * 8) = vr[p]; } } while (0)
    PA_ISSUE(first); PA_COMMIT(0);
    if (first < 8) PA_ISSUE(first + 1);
    LDS_SYNC();
    for (int ti = first; ti <= 8; ++ti) {
        const int bsel = (ti - first) & 1;
        const LAS bf16_t* Ks = (const LAS bf16_t*)(lds + bsel * PBUF_BYTES); const LAS bf16_t* Vt = Ks + 2 * 64 * PKV_STRIDE;
        f32x4 s[4];
#pragma unroll
        for (int kt = 0; kt < 4; ++kt) {
            s[kt] = (f32x4){0.f, 0.f, 0.f, 0.f};
#pragma unroll
            for (int ks = 0; ks < 2; ++ks) {
                const bf16x8 ka = *(const LAS bf16x8*)(Ks + (hl * 64 + kt * 16 + fr) * PKV_STRIDE + ks * 32 + 8 * fq);
                s[kt] = __builtin_amdgcn_mfma_f32_16x16x32_bf16(ka, qf[ks], s[kt], 0, 0, 0);
            }
        }
        const int qoff = qb * 16 + fr; float mx = -1e30f;
        if (ti >= 6) {
#pragma unroll
            for (int kt = 0; kt < 4; ++kt)
#pragma unroll
                for (int i = 0; i < 4; ++i) {
                    const int kk = kt * 16 + 4 * fq + i; int rel = (ti - 8) * 64 + kk - qoff; rel = rel < -128 ? -128 : (rel > 128 ? 128 : rel);
                    const float v = s[kt][i] * 0.125f + Bs[hl * 260 + rel + 128];
                    s[kt][i] = v; mx = fmaxf(mx, v);
                }
        } else {
            const float b0 = Bs[hl * 260];
#pragma unroll
            for (int kt = 0; kt < 4; ++kt)
#pragma unroll
                for (int i = 0; i < 4; ++i) { const float v = s[kt][i] * 0.125f + b0; s[kt][i] = v; mx = fmaxf(mx, v); }
        }
        mx = fmaxf(mx, __shfl_xor(mx, 16)); mx = fmaxf(mx, __shfl_xor(mx, 32));
        const float mnew = fmaxf(mrun, mx), alpha = __expf(mrun - mnew); mrun = mnew;
        float ps = 0.f;
#pragma unroll
        for (int kt = 0; kt < 4; ++kt)
#pragma unroll
            for (int i = 0; i < 4; ++i) { const float p = __expf(s[kt][i] - mnew); s[kt][i] = p; ps += p; }
        lrun = lrun * alpha + ps;
#pragma unroll
        for (int db = 0; db < 4; ++db) o[db] *= alpha;
        bf16x8 pb[2];
#pragma unroll
        for (int kp = 0; kp < 2; ++kp) {
            u32x4 w; w.x = cvt_pk_bf16(s[2 * kp][0], s[2 * kp][1]); w.y = cvt_pk_bf16(s[2 * kp][2], s[2 * kp][3]);
            w.z = cvt_pk_bf16(s[2 * kp + 1][0], s[2 * kp + 1][1]); w.w = cvt_pk_bf16(s[2 * kp + 1][2], s[2 * kp + 1][3]);
            pb[kp] = __builtin_bit_cast(bf16x8, w);
        }
        {
            const unsigned vaddr = (unsigned)(size_t)(Vt + (hl * 64 + 4 * fq + (fr >> 2)) * PKV_STRIDE + 4 * (fr & 3));
            u32x2 r0, r1, r2, r3; u32x4 w;
            tr_read4<0>(vaddr, r0, r1, r2, r3);
            w.x = r0.x; w.y = r0.y; w.z = r1.x; w.w = r1.y; o[0] = __builtin_amdgcn_mfma_f32_16x16x32_bf16(__builtin_bit_cast(bf16x8, w), pb[0], o[0], 0, 0, 0);
            w.x = r2.x; w.y = r2.y; w.z = r3.x; w.w = r3.y; o[0] = __builtin_amdgcn_mfma_f32_16x16x32_bf16(__builtin_bit_cast(bf16x8, w), pb[1], o[0], 0, 0, 0);
            tr_read4<1>(vaddr, r0, r1, r2, r3);
            w.x = r0.x; w.y = r0.y; w.z = r1.x; w.w = r1.y; o[1] = __builtin_amdgcn_mfma_f32_16x16x32_bf16(__builtin_bit_cast(bf16x8, w), pb[0], o[1], 0, 0, 0);
            w.x = r2.x; w.y = r2.y; w.z = r3.x; w.w = r3.y; o[1] = __builtin_amdgcn_mfma_f32_16x16x32_bf16(__builtin_bit_cast(bf16x8, w), pb[1], o[1], 0, 0, 0);
            tr_read4<2>(vaddr, r0, r1, r2, r3);
            w.x = r0.x; w.y = r0.y; w.z = r1.x; w.w = r1.y; o[2] = __builtin_amdgcn_mfma_f32_16x16x32_bf16(__builtin_bit_cast(bf16x8, w), pb[0], o[2], 0, 0, 0);
            w.x = r2.x; w.y = r2.y; w.z = r3.x; w.w = r3.y; o[2] = __builtin_amdgcn_mfma_f32_16x16x32_bf16(__builtin_bit_cast(bf16x8, w), pb[1], o[2], 0, 0, 0);
            tr_read4<3>(vaddr, r0, r1, r2, r3);
            w.x = r0.x; w.y = r0.y; w.z = r1.x; w.w = r1.y; o[3] = __builtin_amdgcn_mfma_f32_16x16x32_bf16(__builtin_bit_cast(bf16x8, w), pb[0], o[3], 0, 0, 0);
            w.x = r2.x; w.y = r2.y; w.z = r3.x; w.w = r3.y; o[3] = __builtin_amdgcn_mfma_f32_16x16x32_bf16(__builtin_bit_cast(bf16x8, w), pb[1], o[3], 0, 0, 0);
        }
        if (ti < 8) { PA_COMMIT(bsel ^ 1); if (ti < 7) PA_ISSUE(ti + 2); }
        LDS_SYNC();
    }
#undef PA_ISSUE
#undef PA_COMMIT
    lrun += __shfl_xor(lrun, 16); lrun += __shfl_xor(lrun, 32);
    const float inv = 1.0f / lrun;
    bf16_t* op = OC + (size_t)(qrow0 + qb * 16 + fr) * D + h * 64 + 4 * fq;
#pragma unroll
    for (int db = 0; db < 4; ++db) { u32x2 w; w.x = cvt_pk_bf16(o[db][0] * inv, o[db][1] * inv); w.y = cvt_pk_bf16(o[db][2] * inv, o[db][3] * inv); *(u32x2*)(op + db * 16) = w; }
}

__device__ __forceinline__ void attn_unit_s(const Args& a, LAS unsigned char* lds, int l, int ux) {
    int tid_ = threadIdx.x; asm volatile("" : "+v"(tid_));
    const int tid = tid_, lane = tid & 63, wave = __builtin_amdgcn_readfirstlane(tid >> 6), fr = lane & 15, fq = lane >> 4;
    const bf16_t* Q = (const bf16_t*)(a.ws + WS_Q); const bf16_t* Kb = (const bf16_t*)(a.ws + WS_K); const bf16_t* Vb = (const bf16_t*)(a.ws + WS_V);
    bf16_t* OC = (bf16_t*)(a.ws + WS_OC);
    const int h = ux & 7, b = ux >> 3, qrow0 = TP + b * SL;
    const bool active = wave == 0;
    LAS float* Bs = (LAS float*)(lds + PATT_BIAS);
    const float* ck = a.in[2] + ((size_t)(l * NBATCH + b) * RC) * 512 + h * 64; const float* cv = a.in[3] + ((size_t)(l * NBATCH + b) * RC) * 512 + h * 64;
    LDS_SYNC();
    for (int i = tid; i < 257; i += 512) Bs[i] = a.in[14][(size_t)(l * 8 + h) * 257 + i];
    bf16x8 qf[2];
    if (active) { const bf16_t* qp = Q + (size_t)(qrow0 + fr) * 512 + h * 64 + 8 * fq; qf[0] = *(const bf16x8*)qp; qf[1] = *(const bf16x8*)(qp + 32); }
    f32x4 o[4]; float mrun = -1e30f, lrun = 0.f;
#pragma unroll
    for (int i = 0; i < 4; ++i) o[i] = (f32x4){0.f, 0.f, 0.f, 0.f};
    f32x4 kf[2], vf[2];
#define SA_ISSUE(ti) do { _Pragma("unroll") for (int p = 0; p < 2; ++p) { const int idx = tid + p * 512, key = idx >> 4, seg = idx & 15; \
        if ((ti) < 8) { kf[p] = *(const f32x4*)(ck + (size_t)((ti) * 64 + key) * 512 + seg * 4); vf[p] = *(const f32x4*)(cv + (size_t)((ti) * 64 + key) * 512 + seg * 4); } \
        else if (key < SL) { const u32x2 kw = *(const u32x2*)(Kb + (size_t)(qrow0 + key) * 512 + h * 64 + seg * 4), vw = *(const u32x2*)(Vb + (size_t)(qrow0 + key) * 512 + h * 64 + seg * 4); \
            kf[p] = (f32x4){bf_lo(kw.x), bf_hi(kw.x), bf_lo(kw.y), bf_hi(kw.y)}; vf[p] = (f32x4){bf_lo(vw.x), bf_hi(vw.x), bf_lo(vw.y), bf_hi(vw.y)}; } \
        else { kf[p] = (f32x4){0.f, 0.f, 0.f, 0.f}; vf[p] = (f32x4){0.f, 0.f, 0.f, 0.f}; } } } while (0)
#define SA_COMMIT(bufb) do { LAS bf16_t* Ks_ = (LAS bf16_t*)(lds + (bufb) * PBUF_BYTES); LAS bf16_t* Vt_ = Ks_ + 2 * 64 * PKV_STRIDE; \
        _Pragma("unroll") for (int p = 0; p < 2; ++p) { const int idx = tid + p * 512, key = idx >> 4, seg = idx & 15; \
        u32x2 kw; kw.x = cvt_pk_bf16(kf[p][0], kf[p][1]); kw.y = cvt_pk_bf16(kf[p][2], kf[p][3]); *(LAS u32x2*)(Ks_ + key * PKV_STRIDE + seg * 4) = kw; \
        const unsigned v01 = cvt_pk_bf16(vf[p][0], vf[p][1]), v23 = cvt_pk_bf16(vf[p][2], vf[p][3]); LAS bf16_t* vp_ = Vt_ + (seg * 4) * PKV_STRIDE + key; \
        vp_[0] = (bf16_t)(v01 & 0xffffu); vp_[PKV_STRIDE] = (bf16_t)(v01 >> 16); vp_[2 * PKV_STRIDE] = (bf16_t)(v23 & 0xffffu); vp_[3 * PKV_STRIDE] = (bf16_t)(v23 >> 16); } } while (0)
    SA_ISSUE(0); SA_COMMIT(0); SA_ISSUE(1);
    LDS_SYNC();
    for (int ti = 0; ti <= 8; ++ti) {
        const int bsel = ti & 1;
        if (active) {
            const LAS bf16_t* Ks = (const LAS bf16_t*)(lds + bsel * PBUF_BYTES); const LAS bf16_t* Vt = Ks + 2 * 64 * PKV_STRIDE;
            f32x4 s[4];
#pragma unroll
            for (int kt = 0; kt < 4; ++kt) {
                s[kt] = (f32x4){0.f, 0.f, 0.f, 0.f};
#pragma unroll
                for (int ks = 0; ks < 2; ++ks) {
                    const bf16x8 ka = *(const LAS bf16x8*)(Ks + (kt * 16 + fr) * PKV_STRIDE + ks * 32 + 8 * fq);
                    s[kt] = __builtin_amdgcn_mfma_f32_16x16x32_bf16(ka, qf[ks], s[kt], 0, 0, 0);
                }
            }
            float mx = -1e30f;
            if (ti >= 6) {
#pragma unroll
                for (int kt = 0; kt < 4; ++kt)
#pragma unroll
                    for (int i = 0; i < 4; ++i) {
                        const int kk = kt * 16 + 4 * fq + i; int rel = (ti - 8) * 64 + kk - fr; rel = rel < -128 ? -128 : (rel > 128 ? 128 : rel);
                        float v = s[kt][i] * 0.125f + Bs[rel + 128];
                        if (ti == 8 && kk >= SL) v = -1e30f;
                        s[kt][i] = v; mx = fmaxf(mx, v);
                    }
            } else {
                const float b0 = Bs[0];
#pragma unroll
                for (int kt = 0; kt < 4; ++kt)
#pragma unroll
                    for (int i = 0; i < 4; ++i) { const float v = s[kt][i] * 0.125f + b0; s[kt][i] = v; mx = fmaxf(mx, v); }
            }
            mx = fmaxf(mx, __shfl_xor(mx, 16)); mx = fmaxf(mx, __shfl_xor(mx, 32));
            const float mnew = fmaxf(mrun, mx), alpha = __expf(mrun - mnew); mrun = mnew;
            float ps = 0.f;
#pragma unroll
            for (int kt = 0; kt < 4; ++kt)
#pragma unroll
                for (int i = 0; i < 4; ++i) { const float p = __expf(s[kt][i] - mnew); s[kt][i] = p; ps += p; }
            lrun = lrun * alpha + ps;
#pragma unroll
            for (int db = 0; db < 4; ++db) o[db] *= alpha;
            bf16x8 pb[2];
#pragma unroll
            for (int kp = 0; kp < 2; ++kp) {
                u32x4 w; w.x = cvt_pk_bf16(s[2 * kp][0], s[2 * kp][1]); w.y = cvt_pk_bf16(s[2 * kp][2], s[2 * kp][3]);
                w.z = cvt_pk_bf16(s[2 * kp + 1][0], s[2 * kp + 1][1]); w.w = cvt_pk_bf16(s[2 * kp + 1][2], s[2 * kp + 1][3]);
                pb[kp] = __builtin_bit_cast(bf16x8, w);
            }
#pragma unroll
            for (int db = 0; db < 4; ++db)
#pragma unroll
                for (int kp = 0; kp < 2; ++kp) {
                    const LAS bf16_t* vp = Vt + (db * 16 + fr) * PKV_STRIDE + kp * 32 + 4 * fq;
                    const u32x2 v0 = *(const LAS u32x2*)vp, v1 = *(const LAS u32x2*)(vp + 16);
                    u32x4 w; w.x = v0.x; w.y = v0.y; w.z = v1.x; w.w = v1.y;
                    o[db] = __builtin_amdgcn_mfma_f32_16x16x32_bf16(__builtin_bit_cast(bf16x8, w), pb[kp], o[db], 0, 0, 0);
                }
        }
        if (ti < 8) { SA_COMMIT(bsel ^ 1); if (ti < 7) SA_ISSUE(ti + 2); }
        LDS_SYNC();
    }
#undef SA_ISSUE
#undef SA_COMMIT
    if (active) {
        lrun += __shfl_xor(lrun, 16); lrun += __shfl_xor(lrun, 32);
        const float inv = 1.0f / lrun;
        bf16_t* op = OC + (size_t)(qrow0 + fr) * D + h * 64 + 4 * fq;
#pragma unroll
        for (int db = 0; db < 4; ++db) { u32x2 w; w.x = cvt_pk_bf16(o[db][0] * inv, o[db][1] * inv); w.y = cvt_pk_bf16(o[db][2] * inv, o[db][3] * inv); *(u32x2*)(op + db * 16) = w; }
    }
}

__device__ __forceinline__ void poolconv_unit(const Args& a, int l, int ux) {
    int tid_ = threadIdx.x; asm volatile("" : "+v"(tid_));
    const int tid = tid_, c = tid & 255, half = tid >> 8;
    const float* PU = (const float*)(a.ws + WS_PU); const float* CIN = (const float*)(a.ws + WS_CIN); const float* CB = (const float*)(a.ws + WS_CB);
    bf16_t* OC = (bf16_t*)(a.ws + WS_OC);
    const int t0 = ux * 64 + half * 32; const bool sample = t0 >= TP;
    const int g = c >> 6, w = 2 << g;
    const float cw0 = a.in[17][(size_t)(l * 3 + 0) * 256 + c], cw1 = a.in[17][(size_t)(l * 3 + 1) * 256 + c], cw2 = a.in[17][(size_t)(l * 3 + 2) * 256 + c], cbias = a.in[18][l * 256 + c];
    const float* sp = a.in[4] + (size_t)l * NBATCH * 15 * 256; const float* sc = a.in[5] + (size_t)l * NBATCH * 2 * 256;
    float sum = 0.f, c1 = 0.f, c2 = 0.f;
    if (!sample) {
        for (int k = 1; k < w; ++k) if (t0 - k >= 0) sum += PU[(size_t)(t0 - k) * 256 + c];
        if (t0 >= 1) c1 = CIN[(size_t)(t0 - 1) * 256 + c];
        if (t0 >= 2) c2 = CIN[(size_t)(t0 - 2) * 256 + c];
    }
    for (int jb = 0; jb < 32; jb += 8) {
        float u8[8], ci8[8], cb8[8], od8[8];
#pragma unroll
        for (int q = 0; q < 8; ++q) {
            const int t = t0 + jb + q;
            u8[q] = PU[(size_t)t * 256 + c]; ci8[q] = CIN[(size_t)t * 256 + c]; cb8[q] = CB[(size_t)t * 256 + c];
            if (!sample) od8[q] = (t - w + 1 >= 0) ? PU[(size_t)(t - w + 1) * 256 + c] : 0.f;
            else { const int b = (t - TP) >> 4, e = ((t - TP) & 15) - w + 1; od8[q] = e >= 0 ? PU[(size_t)(t - w + 1) * 256 + c] : sp[(size_t)(b * 15 + 15 + e) * 256 + c]; }
        }
#pragma unroll
        for (int q = 0; q < 8; ++q) {
            const int t = t0 + jb + q; const float u = u8[q], ci = ci8[q];
            float cnt;
            if (!sample) {
                cnt = (float)((t + 1 < w) ? t + 1 : w);
                if (t >= TP - 15) a.out[O_PP + (size_t)l * 3840 + (size_t)(t - (TP - 15)) * 256 + c] = u;
                if (t >= TP - 2) a.out[O_CP + (size_t)l * 512 + (size_t)(t - (TP - 2)) * 256 + c] = ci;
            } else {
                const int b = (t - TP) >> 4, sq = (t - TP) & 15; cnt = (float)w;
                if (sq == 0) {
                    sum = 0.f; for (int k = 1; k < w; ++k) sum += sp[(size_t)(b * 15 + 15 - k) * 256 + c];
                    c1 = sc[(size_t)(b * 2 + 1) * 256 + c]; c2 = sc[(size_t)(b * 2) * 256 + c];
                }
                if (sq >= 1) a.out[O_PS + (size_t)l * 122880 + (size_t)(b * 15 + sq - 1) * 256 + c] = u;
                if (sq >= 14) a.out[O_CS + (size_t)l * 16384 + (size_t)(b * 2 + sq - 14) * 256 + c] = ci;
            }
            sum += u;
            const float dv = sum / cnt - u;
            sum -= od8[q];
            const float y = cbias + cw0 * c2 + cw1 * c1 + cw2 * ci;
            OC[(size_t)t * D + 512 + c] = (bf16_t)(cvt_pk_bf16(dv, 0.f) & 0xffffu);
            OC[(size_t)t * D + 768 + c] = (bf16_t)(cvt_pk_bf16(cb8[q] * y, 0.f) & 0xffffu);
            c2 = c1; c1 = ci;
        }
    }
}

constexpr int N_ATT_P = 1024, N_ATT_S = 256, N_PC = T / 64;
__device__ __forceinline__ void mixer_phase(const Args& a, LAS unsigned char* lds, int l, int bid, int gdim) {
    for (int u = bid; u < N_ATT_P + N_ATT_S + N_PC; u += gdim) {
        if (u < N_ATT_P) { if (MIXMASK & 1) attn_unit_p(a, lds, l, u); if (REPEAT & 128) attn_unit_p(a, lds, l, u); }
        else if (u < N_ATT_P + N_ATT_S) { if (MIXMASK & 2) attn_unit_s(a, lds, l, u - N_ATT_P); if (REPEAT & 256) attn_unit_s(a, lds, l, u - N_ATT_P); }
        else { if (MIXMASK & 4) poolconv_unit(a, l, u - N_ATT_P - N_ATT_S); if (REPEAT & 512) poolconv_unit(a, l, u - N_ATT_P - N_ATT_S); }
    }
    if (MIXMASK & 8) {
        const float* PU = (const float*)(a.ws + WS_PU); const float* CIN = (const float*)(a.ws + WS_CIN); bf16_t* OC = (bf16_t*)(a.ws + WS_OC);
        int tq = threadIdx.x; asm volatile("" : "+v"(tq));
        for (int i = bid * 512 + tq; i < T * 256; i += gdim * 512) { const size_t t = i >> 8, c = i & 255;
            const bf16_t* XBp = (const bf16_t*)(a.ws + WS_XB); bf16_t* MBp = (bf16_t*)(a.ws + WS_OC); MBp[t * D + c] = XBp[t * D + c]; MBp[t * D + 256 + c] = XBp[t * D + 256 + c]; MBp[t * D + 512 + c] = XBp[t * D + 512 + c]; MBp[t * D + 768 + c] = XBp[t * D + 768 + c]; }
    }
    LDS_SYNC();
}

#define XB_TMO      128
#define XB_XCNT(j)  (256  + 64 * (j))
#define XB_XSUB(j)  (1280 + 64 * (j))
#define XB_XGEN(j)  (2304 + 64 * (j))
#define XB_TOP      3328
#define XB_TOPGEN   3392
#define XCD_BAR_WORDS 3456
#define XB_SPIN_CAP (1u << 20)
__device__ __forceinline__ unsigned xb_ld(unsigned* p)              { return __hip_atomic_load(p, __ATOMIC_RELAXED, __HIP_MEMORY_SCOPE_AGENT); }
__device__ __forceinline__ unsigned xb_add(unsigned* p, unsigned v) { return __hip_atomic_fetch_add(p, v, __ATOMIC_RELAXED, __HIP_MEMORY_SCOPE_AGENT); }
__device__ __forceinline__ unsigned xb_xcc_id() { return (unsigned)__builtin_amdgcn_s_getreg((3 << 11) | 20) & 0xFu; }
#define XB_SPIN(cond, bar) do { unsigned _sp = 0; while (cond) { __builtin_amdgcn_s_sleep(1); \
    if ((++_sp & 255u) == 0u) { if (xb_ld(&(bar)[XB_TMO])) break; if (_sp > XB_SPIN_CAP) { atomicAdd(&(bar)[XB_TMO], 1u); break; } } } } while (0)
struct XcdBarrier { unsigned* bar; unsigned x; volatile LAS unsigned* st; };
__device__ __forceinline__ XcdBarrier xcd_barrier_post(unsigned* bar, volatile LAS unsigned* st) {
    XcdBarrier b; b.bar = bar; b.x = xb_xcc_id(); b.st = st;
    if (threadIdx.x == 0) (void)xb_add(&bar[XB_XCNT(b.x)], 1u);
    return b;
}
__device__ __forceinline__ void xcd_barrier_complete(unsigned* bar, unsigned x, unsigned& nloc, unsigned& nx) {
    const unsigned G = gridDim.x * gridDim.y * gridDim.z;
    unsigned sum, cnt, mine, sp = 0u;
    for (;;) {
        sum = 0u; cnt = 0u; mine = 0u;
#pragma unroll
        for (unsigned j = 0; j < 16; ++j) { const unsigned c = xb_ld(&bar[XB_XCNT(j)]); sum += c; cnt += (c > 0u) ? 1u : 0u; mine = (j == x) ? c : mine; }
        if (sum == G) break;
        __builtin_amdgcn_s_sleep(1);
        if ((++sp & 255u) == 0u) { if (xb_ld(&bar[XB_TMO])) break; if (sp > XB_SPIN_CAP) { atomicAdd(&bar[XB_TMO], 1u); break; } }
    }
    nloc = mine > 0u ? mine : 1u; nx = cnt > 0u ? cnt : 1u;
}
__device__ __forceinline__ void xcd_barrier(const XcdBarrier& b) {
    asm volatile("s_waitcnt vmcnt(0)" ::: "memory");
    __syncthreads();
    if (threadIdx.x == 0) {
        unsigned* bar = b.bar;
        __builtin_amdgcn_s_waitcnt(0);
        unsigned nloc = b.st[0], nx = b.st[1];
        if (nloc == 0u) { xcd_barrier_complete(bar, b.x, nloc, nx); b.st[0] = nloc; b.st[1] = nx; }
        const unsigned old = xb_add(&bar[XB_XSUB(b.x)], 1u);
        const unsigned gen = old / nloc;
        if (old + 1u == (gen + 1u) * nloc) {
            __builtin_amdgcn_fence(__ATOMIC_RELEASE, "agent");
            asm volatile("s_waitcnt vmcnt(0)" ::: "memory");
            const unsigned og = xb_add(&bar[XB_TOP], 1u);
            const unsigned tg = og / nx;
            if (og + 1u == (tg + 1u) * nx) xb_add(&bar[XB_TOPGEN], 1u);
            else XB_SPIN(xb_ld(&bar[XB_TOPGEN]) == tg, bar);
            __builtin_amdgcn_fence(__ATOMIC_ACQUIRE, "agent");
            xb_add(&bar[XB_XGEN(b.x)], 1u);
            asm volatile("s_waitcnt vmcnt(0)" ::: "memory");
        } else {
            XB_SPIN(xb_ld(&bar[XB_XGEN(b.x)]) == gen, bar);
            __builtin_amdgcn_fence(__ATOMIC_ACQUIRE, "agent");
            asm volatile("s_waitcnt vmcnt(0)" ::: "memory");
        }
    }
    __syncthreads();
}

constexpr int N_PHASES = 1 + 8 * DEPTH;
__global__ void __launch_bounds__(512, 2) fwd_kernel(Args a) {
    extern __shared__ __attribute__((aligned(16))) unsigned char lds_raw[];
    LAS unsigned char* lds = (LAS unsigned char*)lds_raw;
    unsigned char* ws = a.ws;
    float* ssq = (float*)(ws + WS_SSQ);
    bf16_t* XB = (bf16_t*)(ws + WS_XB); bf16_t* ACT = (bf16_t*)(ws + WS_ACT);
    volatile LAS unsigned* misc = (volatile LAS unsigned*)(lds + 131072 + 1024);
    if (threadIdx.x < 2) misc[threadIdx.x] = 0u;
    __syncthreads();
    const XcdBarrier xbar = xcd_barrier_post((unsigned*)ws, misc);
    for (int ph = a.ph_lo; ph < a.ph_hi; ++ph) {
        int bid = blockIdx.x, gdim = gridDim.x; asm volatile("" : "+s"(bid), "+s"(gdim));
        if (ph == 0) { if (PHMASK & 1) prologue(a, lds, bid, gdim); if (REPEAT & 1) { __syncthreads(); prologue(a, lds, bid, gdim); } asm volatile("s_waitcnt vmcnt(0) lgkmcnt(0)" ::: "memory"); __syncthreads(); }
        else {
            const int l = (ph - 1) >> 3, s = (ph - 1) & 7;
            const bf16_t* WL = (const bf16_t*)(ws + WS_W) + (size_t)l * LAYER_W_ELEMS;
            pg8::StaticOrder S;
            unsigned* const sready_base = (unsigned*)ws + 3840;
            if (DEFER_S && (s == 0 || s == 2 || s == 6) && ph > 1) {
                const int sp = s == 0 ? 7 : s - 1, lp = s == 0 ? l - 1 : l, KSp = sp == 5 ? 4 : 10;
                if (bid >= gdim - 8 * KSp) {
                    const bf16_t* WLp = (const bf16_t*)(ws + WS_W) + (size_t)lp * LAYER_W_ELEMS;
                    pg8::Gemm g2{sp == 5 ? (const bf16_t*)(ws + WS_MB) : ACT, WLp + (sp == 1 ? W_1OUT : (sp == 5 ? W_O : W_2OUT)), sp == 5 ? D : FF};
                    pg8::SliceOrder SL; SL.init(gdim, bid, KSp);
                    pg8::EpiResid E2{nullptr, XB, ssq + (size_t)(3 * lp + (sp == 1 ? 1 : (sp == 5 ? 2 : 3))) * T * 16, sp == 5 ? 1.0f : 0.5f,
                                     pg8::SplitK{(float*)(ws + WS_SLAB), (unsigned*)ws + 3584 + lp * 64 + sp * 8, KSp}};
                    pg8::gemm_phase(lds, g2, SL, E2);
                    asm volatile("s_waitcnt vmcnt(0)" ::: "memory");
                    __syncthreads();
                    if (threadIdx.x == 0) { __builtin_amdgcn_fence(__ATOMIC_RELEASE, "agent"); asm volatile("s_waitcnt vmcnt(0)" ::: "memory");
                        (void)__hip_atomic_fetch_add(sready_base + lp * 4 + (sp == 1 ? 0 : (sp == 5 ? 1 : 2)), 1u, __ATOMIC_RELAXED, __HIP_MEMORY_SCOPE_AGENT); }
                }
                S.sready = sready_base + lp * 4 + (sp == 1 ? 0 : (sp == 5 ? 1 : 2)); S.expect = 8u * (unsigned)KSp;
            }
            if (s == 0 || s == 6) {
                pg8::Gemm g{XB, WL + (s == 0 ? W_1IN : W_2IN), D}; S.init(T, NIN, gdim, bid);
                pg8::EpiSwiglu E{ssq + (size_t)(3 * l + (s == 0 ? 0 : 2)) * T * 16, ACT};
                if (PHMASK & 2) pg8::gemm_phase(lds, g, S, E);
                if (REPEAT & 2) pg8::gemm_phase(lds, g, S, E);
            } else if (s == 1 || s == 5 || s == 7) {
                pg8::Gemm g{s == 5 ? (const bf16_t*)(ws + WS_MB) : ACT, WL + (s == 1 ? W_1OUT : (s == 5 ? W_O : W_2OUT)), s == 5 ? D : FF}; pg8::SplitOrder SO; SO.init(D, gdim, bid, s == 5 ? 4 : 11);
                pg8::EpiResid E{ph == N_PHASES - 1 ? a.out : nullptr, XB, ssq + (size_t)(3 * l + (s == 1 ? 1 : (s == 5 ? 2 : 3))) * T * 16, s == 5 ? 1.0f : 0.5f,
                                 pg8::SplitK{(float*)(ws + WS_SLAB), (unsigned*)ws + 3584 + ((ph - 1) >> 3) * 64 + s * 8, s == 5 ? 4 : 11}};
                if (DEFER_S && ph != N_PHASES - 1) { pg8::POrder PO; PO.init(D, gdim, bid); pg8::gemm_phase(lds, g, PO, E); }
                else pg8::gemm_phase(lds, g, SO, E);
            } else if (s == 2) {
                pg8::Gemm g{XB, WL + W_MIX, D}; S.init(T, NIN, gdim, bid);
                pg8::EpiMix E{ssq + (size_t)(3 * l + 1) * T * 16, a.in[12] + l * 64, a.in[13] + l * 64, a.in[11] + l * 3072,
                              (bf16_t*)(ws + WS_Q), (bf16_t*)(ws + WS_K), (bf16_t*)(ws + WS_V), (bf16_t*)(ws + WS_G), (float*)(ws + WS_PU), (float*)(ws + WS_CIN), (float*)(ws + WS_CB),
                              a.out + O_KP + (size_t)l * 262144, a.out + O_VP + (size_t)l * 262144, a.out + O_KS + (size_t)l * 262144, a.out + O_VS + (size_t)l * 262144, a.out, (bf16_t*)(ws + WS_VT)};
                if (PHMASK & 8) pg8::gemm_phase(lds, g, S, E);
                if (REPEAT & 8) pg8::gemm_phase(lds, g, S, E);
            } else if (s == 3) {
                if (PHMASK & 16) mixer_phase(a, lds, l, bid, gdim);
                if (REPEAT & 16) mixer_phase(a, lds, l, bid, gdim);
            } else {
                pg8::Gemm g{(const bf16_t*)(ws + WS_OC), WL + W_BR, D}; pg8::SplitOrder SO; SO.init(D, gdim, bid, 4);
                pg8::EpiBranch E{(const bf16_t*)(ws + WS_G), (bf16_t*)(ws + WS_MB), a.out, pg8::SplitK{(float*)(ws + WS_SLAB), (unsigned*)ws + 3584 + ((ph - 1) >> 3) * 64 + s * 8, 4}};
                if (PHMASK & 32) pg8::gemm_phase(lds, g, SO, E);
            }
        }
        if (ph + 1 < a.ph_hi) { if (ph == a.ph_lo) cg::this_grid().sync(); else xcd_barrier(xbar); if (REPEAT & 64) xcd_barrier(xbar); }
    }
}

extern "C" void kernel_launch(void* const* d_in, const int* in_sizes, int n_in, void* d_out, int out_size, void* d_ws, size_t ws_size, hipStream_t stream) {
    static int grid = 0;
    if (grid == 0) {
        if (n_in != 26 || out_size != (int)O_END || ws_size < WS_END) { fprintf(stderr, "kernel_launch: unexpected shapes: n_in %d out %d ws %zu\n", n_in, out_size, ws_size); grid = -1; return; }
        int dev = 0, cus = 0, per_cu = 0;
        hipGetDevice(&dev); hipDeviceGetAttribute(&cus, hipDeviceAttributeMultiprocessorCount, dev);
        if (hipFuncSetAttribute((const void*)fwd_kernel, hipFuncAttributeMaxDynamicSharedMemorySize, LDS_BYTES) != hipSuccess) { fprintf(stderr, "kernel_launch: hipFuncSetAttribute failed\n"); grid = -1; return; }
        hipOccupancyMaxActiveBlocksPerMultiprocessor(&per_cu, (const void*)fwd_kernel, 512, LDS_BYTES);
        (void)hipGetLastError();
        if (per_cu < 1) per_cu = 1;
        grid = cus;
        if (cus != 256) { fprintf(stderr, "kernel_launch: built for 256 CUs (one prompt tile per CU in the N = 1024 GEMMs), got %d\n", cus); grid = -1; return; }
        fprintf(stderr, "kernel_launch: cus %d per_cu %d grid %d\n", cus, per_cu, grid);
    }
    if (grid < 0) return;
    Args a{};
    for (int i = 0; i < 26; ++i) a.in[i] = (const float*)d_in[i];
    a.out = (float*)d_out; a.ws = (unsigned char*)d_ws;
    if (hipMemsetAsync(d_ws, 0, 16384, stream) != hipSuccess) { fprintf(stderr, "kernel_launch: memset of the barrier words failed\n"); return; }
#if MK_ONE_LAUNCH
    a.ph_lo = 0; a.ph_hi = N_PHASES;
    void* args[] = {&a};
    hipError_t e = hipLaunchCooperativeKernel((const void*)fwd_kernel, dim3(grid), dim3(512), args, LDS_BYTES, stream);
    if (e != hipSuccess) fprintf(stderr, "cooperative launch failed: %s (grid %d)\n", hipGetErrorString(e), grid);
#else
    for (int ph = 0; ph < N_PHASES; ++ph) {
        a.ph_lo = ph; a.ph_hi = ph + 1;
        hipLaunchKernelGGL(fwd_kernel, dim3(grid), dim3(512), LDS_BYTES, stream, a);
    }
#endif
}
```

```cpp
#include <hip/hip_runtime.h>
#include <hip/hip_cooperative_groups.h>
#include <cstdio>
#include <cstdint>
namespace cg = cooperative_groups;

#ifndef PHMASK
#define PHMASK 63
#endif
#ifndef MIXMASK
#define MIXMASK 7
#endif
#ifndef PROBE_G
#define PROBE_G 0
#endif
#ifndef PROBE_M
#define PROBE_M 0
#endif
#ifndef PROBE_NOG
#define PROBE_NOG 0
#endif
#ifndef REPEAT
#define REPEAT 0
#endif
#ifndef DEFER_S
#define DEFER_S 1
#endif
#ifndef MK_ONE_LAUNCH
#define MK_ONE_LAUNCH 1
#endif

#define LAS __attribute__((address_space(3)))
typedef unsigned short bf16_t;
typedef short bf16x8 __attribute__((ext_vector_type(8)));
typedef short s16x4 __attribute__((ext_vector_type(4)));
typedef float f32x4 __attribute__((ext_vector_type(4)));
typedef unsigned u32x4 __attribute__((ext_vector_type(4)));
typedef unsigned u32x2 __attribute__((ext_vector_type(2)));

constexpr int TP = 16384, TS = 512, T = TP + TS, D = 1024, FF = 2816, NIN = 5632, DEPTH = 4;
constexpr int NBATCH = 32, SL = 16, RC = 512;
constexpr float EPS = 1e-6f;
constexpr size_t O_KP = (size_t)T * D, O_VP = O_KP + 1048576, O_PP = O_VP + 1048576, O_CP = O_PP + 15360, O_KS = O_CP + 2048,
                 O_VS = O_KS + 1048576, O_PS = O_VS + 1048576, O_CS = O_PS + 491520, O_END = O_CS + 65536;
constexpr size_t MiB = 1u << 20;
constexpr size_t WS_SSQ = 584 * MiB;
constexpr size_t WS_W = 1 * MiB, LAYER_W_ELEMS = 25165824;
constexpr size_t W_1IN = 0, W_1OUT = 5767168, W_MIX = 8650752, W_BR = 14417920, W_O = 15466496, W_2IN = 16515072, W_2OUT = 22282240;
constexpr size_t WS_XB = 193 * MiB, WS_ACT = 226 * MiB, WS_Q = 317 * MiB, WS_K = 334 * MiB, WS_V = 351 * MiB, WS_PU = 368 * MiB, WS_CIN = 385 * MiB,
                 WS_CB = 402 * MiB, WS_G = 419 * MiB, WS_OC = 518 * MiB, WS_MB = 551 * MiB, WS_VT = 598 * MiB, WS_SLAB = 615 * MiB, WS_END = 637 * MiB;
constexpr int LDS_BYTES = 147456;

struct Args {
    const float* in[26];
    float* out; unsigned char* ws;
    int ph_lo, ph_hi;
};

typedef float f32x2_t __attribute__((ext_vector_type(2)));
typedef __bf16 bf16x2_t __attribute__((ext_vector_type(2)));
__device__ __forceinline__ unsigned cvt_pk_bf16(float lo, float hi) { const f32x2_t v = {lo, hi}; return __builtin_bit_cast(unsigned, __builtin_convertvector(v, bf16x2_t)); }
__device__ __forceinline__ float bf_lo(unsigned w) { return __uint_as_float(w << 16); }
__device__ __forceinline__ float bf_hi(unsigned w) { return __uint_as_float(w & 0xffff0000u); }
__device__ __forceinline__ float fast_sigmoid(float y) { return __builtin_amdgcn_rcpf(1.0f + __expf(-y)); }

__device__ __forceinline__ float row_rstd(const float* part, int row) {
    const f32x4* p = (const f32x4*)(part + (size_t)row * 16);
    const f32x4 a = p[0], b = p[1], c = p[2], d = p[3];
    const float s = ((a[0] + a[1]) + (a[2] + a[3])) + ((b[0] + b[1]) + (b[2] + b[3])) + ((c[0] + c[1]) + (c[2] + c[3])) + ((d[0] + d[1]) + (d[2] + d[3]));
    return __builtin_amdgcn_rsqf(s * (1.0f / 1024.0f) + 1e-6f);
}

namespace pg8 {
constexpr int BM = 256, BK = 64, HALF = 128, HTB = HALF * BK * 2, STAGE_BYTES = 8 * HTB, NXCD = 8, WGM = 4;
__host__ __device__ __forceinline__ int lds_byte(int r, int c) { const int st = (r >> 4) * 2 + (c >> 5), rr = r & 15, cc = c & 31, ob = rr * 64 + cc * 2; return st * 1024 + (ob ^ (((ob >> 9) & 1) << 5)); }
__host__ __device__ __forceinline__ void stage_rc(int b, int& R, int& C) { const int st = b / 1024, sb = b % 1024, swz = sb ^ (((sb >> 9) & 1) << 5); R = (st >> 1) * 16 + swz / 64; C = (st & 1) * 32 + (swz % 64) / 2; }
__host__ __device__ __forceinline__ int perm32(int rho) { const int n = rho >> 4, i = rho & 15; return 8 * (i >> 2) + 4 * n + (i & 3); }

struct Unit { int pm, pn, ks, nt, kb; };
struct Gemm { const bf16_t* A; const bf16_t* Bt; int K; };

struct StaticOrder {
    int nM, nN, nwg, G, c;
    __device__ void init(int M, int N, int G_, int c_) { nM = M / BM; nN = N / BM; nwg = nM * nN; G = G_; c = c_; }
    __device__ bool next(int i, Unit& u) const {
        const long L = (long)i * G + c; if (L >= nwg) return false;
        int wgid = (int)L; { const int q = nwg / NXCD, r = nwg % NXCD, xcd = wgid % NXCD, off = wgid / NXCD; wgid = (xcd < r ? xcd * (q + 1) : r * (q + 1) + (xcd - r) * q) + off; }
        const int nig = WGM * nN, gid = wgid / nig, fm = gid * WGM, gsz = (nM - fm) < WGM ? (nM - fm) : WGM;
        u.pm = fm + ((wgid % nig) % gsz); u.pn = (wgid % nig) / gsz; u.ks = -1; u.nt = 0; u.kb = 0; return true;
    }
    unsigned* sready = nullptr; unsigned expect = 0;
    __device__ __forceinline__ void a_ready(const Unit& u) const {
        if (sready == nullptr || u.pm < 64) return;
        if (threadIdx.x == 0) {
            unsigned sp = 0;
            while (__hip_atomic_load(sready, __ATOMIC_RELAXED, __HIP_MEMORY_SCOPE_AGENT) < expect) { __builtin_amdgcn_s_sleep(2); if (++sp > (1u << 22)) break; }
            __builtin_amdgcn_fence(__ATOMIC_ACQUIRE, "agent");
            asm volatile("s_waitcnt vmcnt(0)" ::: "memory");
        }
        __builtin_amdgcn_s_barrier(); asm volatile("" ::: "memory");
    }
};

struct SplitOrder {
    StaticOrder P; int c, KS;
    __device__ void init(int N, int G_, int c_, int KS_) { P.init(TP, N, G_, c_); c = c_; KS = KS_; }
    __device__ bool next(int i, Unit& u) const {
        if (i == 0) return P.next(0, u);
        if (i > 1 || c >= 8 * KS) return false;
        const int tile = c / KS; u.pm = 64 + (tile & 1); u.pn = tile >> 1; u.ks = c - tile * KS; u.nt = 4; u.kb = u.ks * 512; return true;
    }
    __device__ __forceinline__ void a_ready(const Unit&) const {}
};
struct POrder {
    StaticOrder P;
    __device__ void init(int N, int G_, int c_) { P.init(TP, N, G_, c_); }
    __device__ bool next(int i, Unit& u) const { return i == 0 ? P.next(0, u) : false; }
    __device__ __forceinline__ void a_ready(const Unit&) const {}
};
struct SliceOrder {
    int j, KS;
    __device__ void init(int G_, int c_, int KS_) { KS = KS_; j = c_ - (G_ - 8 * KS_); }
    __device__ bool next(int i, Unit& u) const {
        if (i > 0 || j < 0) return false;
        const int tile = j / KS; u.pm = 64 + (tile & 1); u.pn = tile >> 1; u.ks = j - tile * KS; u.nt = (KS == 10 && u.ks >= 8) ? 6 : 4; u.kb = (KS == 10 && u.ks == 9) ? 38 * 128 : u.ks * 512; return true;
    }
    __device__ __forceinline__ void a_ready(const Unit&) const {}
};

template <class Epi, class Sched>
__device__ __forceinline__ void gemm_phase(LAS unsigned char* lds, const Gemm g, const Sched& S, const Epi& E) {
    int tid_ = threadIdx.x; asm volatile("" : "+v"(tid_));
    const int tid = tid_, wid = __builtin_amdgcn_readfirstlane(tid >> 6), lane = tid & 63, wr = wid >> 2, wc = wid & 3, fr = lane & 15, fq = lane >> 4;
    const int K = g.K, ntfull = K / BK;
    unsigned voffA[2], voffB[2];
#pragma unroll
    for (int i = 0; i < 2; ++i) { int R, C; stage_rc(tid * 16 + i * 8192, R, C); const int Rb = (R & ~31) + perm32(R & 31);
        voffA[i] = (unsigned)(R * K + C) * 2u; voffB[i] = (unsigned)(Rb * K + C) * 2u; }
    const size_t kstep = (size_t)(BK * 2);
    const size_t hstep = (size_t)HALF * K * 2;
    const size_t tstep = 2 * hstep;
    const unsigned ldsw = (unsigned)wid * 1024u;
    const int aoff = lds_byte(wr * 64 + fr, fq * 8), boff = lds_byte(wc * 32 + fr, fq * 8);
#define PG8_SA(b, h) (((b) * 2 + (h)) * HTB)
#define PG8_SB(b, h) ((4 + (b) * 2 + (h)) * HTB)
#define PG8_STAGE(bufoff, gbase, voff) do { _Pragma("unroll") for (int _i = 0; _i < 2; ++_i) \
        __builtin_amdgcn_global_load_lds((const unsigned*)((const char*)(gbase) + (voff)[_i]), (LAS unsigned*)(lds + (bufoff) + ldsw + _i * 8192), 16, 0, 0); } while (0)
#define PG8_LDA(dst, b, h) do { _Pragma("unroll") for (int m = 0; m < 4; ++m) _Pragma("unroll") for (int k = 0; k < 2; ++k) dst[m][k] = *(const LAS bf16x8*)(lds + PG8_SA(b, h) + aoff + m * 2048 + k * 1024); } while (0)
#define PG8_LDB(dst, b, h) do { _Pragma("unroll") for (int n = 0; n < 2; ++n) _Pragma("unroll") for (int k = 0; k < 2; ++k) dst[n][k] = *(const LAS bf16x8*)(lds + PG8_SB(b, h) + boff + n * 2048 + k * 1024); } while (0)
#define PG8_MMA(ai, bj, At, Bt) do { __builtin_amdgcn_s_setprio(1); _Pragma("unroll") for (int m = 0; m < 4; ++m) _Pragma("unroll") for (int n = 0; n < 2; ++n) _Pragma("unroll") for (int k = 0; k < 2; ++k) \
        acc[ai][bj][m][n] = __builtin_amdgcn_mfma_f32_16x16x32_bf16(Bt[n][k], At[m][k], acc[ai][bj][m][n], 0, 0, 0); __builtin_amdgcn_s_setprio(0); } while (0)
#define PG8_WAIT_V(n) asm volatile("s_waitcnt vmcnt(" #n ")" ::: "memory")
#define PG8_WAIT_L(n) asm volatile("s_waitcnt lgkmcnt(" #n ")" ::: "memory")
#define PG8_BAR __builtin_amdgcn_s_barrier()
#define PG8_SCHED __builtin_amdgcn_sched_barrier(0)
    Unit cur, nxt; int ui = 0;
    if (!S.next(0, cur)) return;
    S.a_ready(cur);
    f32x4 acc[2][2][4][2];
#pragma unroll
    for (int a = 0; a < 2; ++a)
#pragma unroll
        for (int b = 0; b < 2; ++b)
#pragma unroll
            for (int m = 0; m < 4; ++m)
#pragma unroll
                for (int n = 0; n < 2; ++n) acc[a][b][m][n] = (f32x4){0.f, 0.f, 0.f, 0.f};
    bf16x8 At[4][2], B0[2][2], B1[2][2];
    const char* cA = (const char*)g.A + (size_t)cur.pm * tstep + cur.kb; const char* cB = (const char*)g.Bt + (size_t)cur.pn * tstep + cur.kb;
    PG8_STAGE(PG8_SB(0, 0), cB, voffB); PG8_STAGE(PG8_SB(0, 1), cB + hstep, voffB); PG8_STAGE(PG8_SA(0, 0), cA, voffA); PG8_STAGE(PG8_SA(0, 1), cA + hstep, voffA);
    if (wr == 1) PG8_BAR;
    PG8_WAIT_V(2); PG8_BAR;
    PG8_STAGE(PG8_SB(1, 0), cB + kstep, voffB); PG8_STAGE(PG8_SA(1, 0), cA + kstep, voffA); PG8_STAGE(PG8_SB(1, 1), cB + hstep + kstep, voffB);
    PG8_WAIT_V(6); PG8_BAR;
    for (;;) {
        const bool has_next = S.next(ui + 1, nxt);
        const char* nA = has_next ? (const char*)g.A + (size_t)nxt.pm * tstep + nxt.kb : cA; const char* nB = has_next ? (const char*)g.Bt + (size_t)nxt.pn * tstep + nxt.kb : cB;
        const int nt = cur.nt ? cur.nt : ntfull;
        for (int t = 0; t < nt; t += 2) {
            const bool last = (t == nt - 2);
            if (last && has_next) S.a_ready(nxt);
            const char* a1 = cA + (size_t)(t + 1) * kstep;
            const char* a2 = last ? nA : cA + (size_t)(t + 2) * kstep; const char* b2 = last ? nB : cB + (size_t)(t + 2) * kstep;
            const char* a3 = a2 + kstep; const char* b3 = b2 + kstep;
            if constexpr (Epi::HAS_MID) { if (t == 8 || t == 12) { E.mid(acc, cur, t, wr, wc, fr, fq); PG8_SCHED; } }
            PG8_LDB(B0, 0, 0); PG8_LDB(B1, 0, 1); PG8_SCHED; PG8_LDA(At, 0, 0); PG8_STAGE(PG8_SA(1, 1), a1 + hstep, voffA);
            PG8_WAIT_V(8); PG8_WAIT_L(0); PG8_BAR; PG8_MMA(0, 0, At, B0); PG8_MMA(0, 1, At, B1); PG8_BAR; PG8_SCHED;
            PG8_LDA(At, 0, 1); PG8_STAGE(PG8_SB(0, 0), b2, voffB); PG8_STAGE(PG8_SB(0, 1), b2 + hstep, voffB); PG8_STAGE(PG8_SA(0, 0), a2, voffA);
            PG8_WAIT_V(8); PG8_WAIT_L(0); PG8_BAR; PG8_MMA(1, 0, At, B0); PG8_MMA(1, 1, At, B1); PG8_BAR; PG8_SCHED;
            PG8_LDB(B0, 1, 0); PG8_LDB(B1, 1, 1); PG8_SCHED; PG8_LDA(At, 1, 0); PG8_STAGE(PG8_SA(0, 1), a2 + hstep, voffA);
            PG8_WAIT_V(8); PG8_WAIT_L(0); PG8_BAR; PG8_MMA(0, 0, At, B0); PG8_MMA(0, 1, At, B1); PG8_BAR; PG8_SCHED;
            PG8_LDA(At, 1, 1); PG8_STAGE(PG8_SB(1, 0), b3, voffB); PG8_STAGE(PG8_SB(1, 1), b3 + hstep, voffB); PG8_STAGE(PG8_SA(1, 0), a3, voffA);
            PG8_WAIT_V(8); PG8_WAIT_L(0); PG8_BAR; PG8_MMA(1, 0, At, B0); PG8_MMA(1, 1, At, B1); PG8_BAR; PG8_SCHED;
        }
        if (wr == 0) PG8_BAR;
        E(acc, cur, wr, wc, fr, fq, lds);
        if (!has_next) break;
#pragma unroll
        for (int a = 0; a < 2; ++a)
#pragma unroll
            for (int b = 0; b < 2; ++b)
#pragma unroll
                for (int m = 0; m < 4; ++m)
#pragma unroll
                    for (int n = 0; n < 2; ++n) acc[a][b][m][n] = (f32x4){0.f, 0.f, 0.f, 0.f};
        cur = nxt; cA = nA; cB = nB; ++ui;
        if (wr == 1) PG8_BAR;
    }
    PG8_WAIT_V(0);
    PG8_BAR;
#undef PG8_SA
#undef PG8_SB
#undef PG8_STAGE
#undef PG8_LDA
#undef PG8_LDB
#undef PG8_MMA
#undef PG8_WAIT_V
#undef PG8_WAIT_L
#undef PG8_BAR
#undef PG8_SCHED
}

typedef f32x4 Acc[2][2][4][2];


struct SplitK {
    float* slab; unsigned* cnt; int KS;
    __device__ __forceinline__ void exchange(const Acc& acc, const Unit& u, int wid, int lane) const {
        const int tile = (u.pm - 64) + 2 * u.pn;
        f32x4* dst = (f32x4*)slab + ((size_t)(tile * KS + u.ks) * 8 + wid) * 2048 + lane;
#pragma unroll
        for (int ai = 0; ai < 2; ++ai)
#pragma unroll
            for (int bj = 0; bj < 2; ++bj)
#pragma unroll
                for (int m = 0; m < 4; ++m)
#pragma unroll
                    for (int n = 0; n < 2; ++n) dst[(((ai * 2 + bj) * 4 + m) * 2 + n) * 64] = acc[ai][bj][m][n];
        asm volatile("s_waitcnt vmcnt(0)" ::: "memory");
        __builtin_amdgcn_s_barrier();
        if (wid == 0 && lane == 0) {
            __builtin_amdgcn_fence(__ATOMIC_RELEASE, "agent");
            asm volatile("s_waitcnt vmcnt(0)" ::: "memory");
            (void)__hip_atomic_fetch_add(cnt + tile, 1u, __ATOMIC_RELAXED, __HIP_MEMORY_SCOPE_AGENT);
            unsigned sp = 0;
            while (__hip_atomic_load(cnt + tile, __ATOMIC_RELAXED, __HIP_MEMORY_SCOPE_AGENT) < (unsigned)KS) { __builtin_amdgcn_s_sleep(2); if (++sp > (1u << 22)) break; }
            __builtin_amdgcn_fence(__ATOMIC_ACQUIRE, "agent");
            asm volatile("s_waitcnt vmcnt(0)" ::: "memory");
        }
        __builtin_amdgcn_s_barrier(); asm volatile("" ::: "memory");
    }
    template <int NS> __device__ __forceinline__ f32x4 sum(int tile, int wid, int lane, int q) const {
        const f32x4* p = (const f32x4*)slab + ((size_t)(tile * NS) * 8 + wid) * 2048 + q * 64 + lane;
        f32x4 v[NS];
#pragma unroll
        for (int i = 0; i < NS; ++i) v[i] = p[(size_t)i * 8 * 2048];
        f32x4 t = v[0];
#pragma unroll
        for (int i = 1; i < NS; ++i) t += v[i];
        return t;
    }
    template <int NS, int NQ> __device__ __forceinline__ void sumq(int tile, int wid, int lane, const int (&q)[NQ], f32x4 (&out)[NQ]) const {
        const f32x4* p = (const f32x4*)slab + ((size_t)(tile * NS) * 8 + wid) * 2048 + lane;
        f32x4 v[NQ][NS];
#pragma unroll
        for (int j = 0; j < NQ; ++j)
#pragma unroll
            for (int i = 0; i < NS; ++i) v[j][i] = p[(size_t)i * 8 * 2048 + q[j] * 64];
#pragma unroll
        for (int j = 0; j < NQ; ++j) { f32x4 t = v[j][0];
#pragma unroll
            for (int i = 1; i < NS; ++i) t += v[j][i];
            out[j] = t; }
    }
    __device__ __forceinline__ f32x4 part(int tile, int slice, int wid, int lane, int q) const {
        return *((const f32x4*)slab + ((size_t)(tile * KS + slice) * 8 + wid) * 2048 + q * 64 + lane);
    }
};

struct EpiSwiglu {
    static constexpr bool HAS_MID = false;
    const float* ssq; bf16_t* act;
    __device__ __forceinline__ void operator()(Acc& acc, const Unit& u, int wr, int wc, int fr, int fq, LAS unsigned char* lds) const {
        const int row0 = u.pm * BM + wr * 64 + fr, col = u.pn * 128 + wc * 32 + 8 * fq;
#pragma unroll
        for (int ai = 0; ai < 2; ++ai)
#pragma unroll
            for (int m = 0; m < 4; ++m) {
                const int row = row0 + ai * HALF + m * 16;
                const float rs = row_rstd(ssq, row);
                float o[8];
#pragma unroll
                for (int n = 0; n < 2; ++n)
#pragma unroll
                    for (int i = 0; i < 4; ++i) { const float gv = acc[ai][0][m][n][i] * rs, uv = acc[ai][1][m][n][i] * rs; o[4 * n + i] = gv * fast_sigmoid(gv) * uv; }
                u32x4 w; w.x = cvt_pk_bf16(o[0], o[1]); w.y = cvt_pk_bf16(o[2], o[3]); w.z = cvt_pk_bf16(o[4], o[5]); w.w = cvt_pk_bf16(o[6], o[7]);
                *(u32x4*)(act + (size_t)row * FF + col) = w;
                asm volatile("" ::: "memory");
            }
    }
};

struct EpiResid {
    static constexpr bool HAS_MID = false;
    float* x; bf16_t* xb; float* ssq_out; float scale; SplitK sk;
    __device__ __forceinline__ void group(const f32x4 (&v)[2][2], int row, int col0, int pn, int wc, int fq) const {
        float ss = 0.f;
#pragma unroll
        for (int bj = 0; bj < 2; ++bj) {
            bf16_t* pb = xb + (size_t)row * D + col0 + bj * HALF;
            const u32x4 xo = *(const u32x4*)pb;
            f32x4 a = (f32x4){bf_lo(xo.x), bf_hi(xo.x), bf_lo(xo.y), bf_hi(xo.y)}, b = (f32x4){bf_lo(xo.z), bf_hi(xo.z), bf_lo(xo.w), bf_hi(xo.w)};
            a += v[bj][0] * scale; b += v[bj][1] * scale;
            if (x) { float* p = x + (size_t)row * D + col0 + bj * HALF; *(f32x4*)p = a; *(f32x4*)(p + 4) = b; }
            else {
                ss += (a[0] * a[0] + a[1] * a[1]) + (a[2] * a[2] + a[3] * a[3]) + (b[0] * b[0] + b[1] * b[1]) + (b[2] * b[2] + b[3] * b[3]);
                u32x4 w; w.x = cvt_pk_bf16(a[0], a[1]); w.y = cvt_pk_bf16(a[2], a[3]); w.z = cvt_pk_bf16(b[0], b[1]); w.w = cvt_pk_bf16(b[2], b[3]);
                *(u32x4*)pb = w;
            }
        }
        if (x) return;
        ss += __shfl_xor(ss, 16); ss += __shfl_xor(ss, 32);
        if (fq == 0) ssq_out[(size_t)row * 16 + pn * 4 + wc] = ss;
    }
    __device__ __forceinline__ void operator()(Acc& acc, const Unit& u, int wr, int wc, int fr, int fq, LAS unsigned char* lds) const {
        const int row0 = u.pm * BM + wr * 64 + fr, col0 = u.pn * BM + wc * 32 + 8 * fq;
        if (u.ks >= 0) {
            const int wid = wr * 4 + wc, lane = fq * 16 + fr, tile = (u.pm - 64) + 2 * u.pn;
            sk.exchange(acc, u, wid, lane);
            if (sk.KS >= 10) {
                if (u.ks < 8) {
                    const int ai = u.ks >> 2, m = u.ks & 3;
                    f32x4 v[2][2];
#pragma unroll
                    for (int bj = 0; bj < 2; ++bj) { const int q0 = ((ai * 2 + bj) * 4 + m) * 2; const int qq[2] = {q0, q0 + 1};
                        if (sk.KS == 11) sk.sumq<11, 2>(tile, wid, lane, qq, v[bj]); else sk.sumq<10, 2>(tile, wid, lane, qq, v[bj]); }
                    group(v, row0 + ai * HALF + m * 16, col0, u.pn, wc, fq);
                }
            } else {
#pragma unroll
                for (int pp = 0; pp < 2; ++pp) {
                    const int pair = u.ks * 2 + pp, ai = pair >> 2, m = pair & 3;
                    const int q0 = (ai * 2 * 4 + m) * 2, q1 = ((ai * 2 + 1) * 4 + m) * 2; const int qq[4] = {q0, q0 + 1, q1, q1 + 1};
                    f32x4 t[4]; sk.sumq<4, 4>(tile, wid, lane, qq, t);
                    const f32x4 v[2][2] = {{t[0], t[1]}, {t[2], t[3]}};
                    group(v, row0 + ai * HALF + m * 16, col0, u.pn, wc, fq);
                }
            }
            return;
        }
#pragma unroll
        for (int ai = 0; ai < 2; ++ai)
#pragma unroll
            for (int m = 0; m < 4; ++m) {
                const f32x4 v[2][2] = {{acc[ai][0][m][0], acc[ai][0][m][1]}, {acc[ai][1][m][0], acc[ai][1][m][1]}};
                group(v, row0 + ai * HALF + m * 16, col0, u.pn, wc, fq);
                asm volatile("" ::: "memory");
            }
    }
};

struct EpiMix {
    static constexpr bool HAS_MID = false;
    const float* ssq; const float* qn; const float* kn; const float* gate_b;
    bf16_t *Q, *Kb, *Vb, *G; float *PU, *CIN, *CB;
    float* kout_p; float* vout_p; float* kout_s; float* vout_s;
    float* xprobe; bf16_t* VT;
    __device__ __forceinline__ void operator()(Acc& acc, const Unit& u, int wr, int wc, int fr, int fq, LAS unsigned char* lds) const {
        const int row0 = u.pm * BM + wr * 64 + fr, pn = u.pn;
        const bool tail = u.pm >= 62;
        if (pn < 4) {
            const bool isk = pn >= 2; const float* nw = isk ? kn : qn; const int head = (pn & 1) * 4 + wc;
            float wv[2][8];
#pragma unroll
            for (int bj = 0; bj < 2; ++bj)
#pragma unroll
                for (int j = 0; j < 8; ++j) wv[bj][j] = nw[32 * bj + 8 * fq + j];
            bf16_t* dst = isk ? Kb : Q;
#pragma unroll
            for (int ai = 0; ai < 2; ++ai)
#pragma unroll
                for (int m = 0; m < 4; ++m) {
                    const int row = row0 + ai * HALF + m * 16;
                    const float rs = row_rstd(ssq, row);
                    float v[2][8]; float ss = 0.f;
#pragma unroll
                    for (int bj = 0; bj < 2; ++bj)
#pragma unroll
                        for (int n = 0; n < 2; ++n)
#pragma unroll
                            for (int i = 0; i < 4; ++i) { const float q = acc[ai][bj][m][n][i] * rs; v[bj][4 * n + i] = q; ss += q * q; }
                    ss += __shfl_xor(ss, 16); ss += __shfl_xor(ss, 32);
                    const float hr = __builtin_amdgcn_rsqf(ss * (1.0f / 64.0f) + EPS);
#pragma unroll
                    for (int bj = 0; bj < 2; ++bj) {
#pragma unroll
                        for (int j = 0; j < 8; ++j) v[bj][j] = v[bj][j] * hr * wv[bj][j];
                        u32x4 w; w.x = cvt_pk_bf16(v[bj][0], v[bj][1]); w.y = cvt_pk_bf16(v[bj][2], v[bj][3]); w.z = cvt_pk_bf16(v[bj][4], v[bj][5]); w.w = cvt_pk_bf16(v[bj][6], v[bj][7]);
                        const int c = head * 64 + 32 * bj + 8 * fq;
                        *(u32x4*)(dst + (size_t)row * 512 + c) = w;
                        if (isk && tail) {
                            float* o = (row < TP ? kout_p + (size_t)(row - (TP - 512)) * 512 : kout_s + (size_t)(row - TP) * 512) + c;
                            *(f32x4*)o = (f32x4){v[bj][0], v[bj][1], v[bj][2], v[bj][3]}; *(f32x4*)(o + 4) = (f32x4){v[bj][4], v[bj][5], v[bj][6], v[bj][7]};
                        }
                    }
                    asm volatile("" ::: "memory");
                }
        } else if (pn == 7 || pn == 8) {
            const int c = (pn - 7) * 128 + wc * 32 + 8 * fq;
#pragma unroll
            for (int ai = 0; ai < 2; ++ai)
#pragma unroll
                for (int m = 0; m < 4; ++m) {
                    const int row = row0 + ai * HALF + m * 16;
                    const float rs = row_rstd(ssq, row), rs2 = rs * rs;
                    float* o = CIN + (size_t)row * 256 + c;
                    *(f32x4*)o = acc[ai][0][m][0] * acc[ai][1][m][0] * rs2; *(f32x4*)(o + 4) = acc[ai][0][m][1] * acc[ai][1][m][1] * rs2;
                    asm volatile("" ::: "memory");
                }
        } else if (pn < 10) {
            const int cl = wc * 32 + 8 * fq;
#pragma unroll
            for (int ai = 0; ai < 2; ++ai)
#pragma unroll
                for (int m = 0; m < 4; ++m) {
                    const int row = row0 + ai * HALF + m * 16;
                    const float rs = row_rstd(ssq, row);
#pragma unroll
                    for (int bj = 0; bj < 2; ++bj) {
                        const f32x4 a = acc[ai][bj][m][0] * rs, b = acc[ai][bj][m][1] * rs;
                        const int c = bj * HALF + cl;
                        if (pn < 6) {
                            const int cv = (pn - 4) * 256 + c;
                            u32x4 w; w.x = cvt_pk_bf16(a[0], a[1]); w.y = cvt_pk_bf16(a[2], a[3]); w.z = cvt_pk_bf16(b[0], b[1]); w.w = cvt_pk_bf16(b[2], b[3]);
                            *(u32x4*)(Vb + (size_t)row * 512 + cv) = w;
                            if (tail) { float* o = (row < TP ? vout_p + (size_t)(row - (TP - 512)) * 512 : vout_s + (size_t)(row - TP) * 512) + cv; *(f32x4*)o = a; *(f32x4*)(o + 4) = b; }
                        } else {
                            float* o = (pn == 6 ? PU : CB) + (size_t)row * 256 + c; *(f32x4*)o = a; *(f32x4*)(o + 4) = b;
                        }
                    }
                    asm volatile("" ::: "memory");
                }
        } else {
            const int cg0 = (pn - 10) * 256 + wc * 32 + 8 * fq;
            f32x4 gb[2][2];
#pragma unroll
            for (int bj = 0; bj < 2; ++bj)
#pragma unroll
                for (int n = 0; n < 2; ++n) gb[bj][n] = *(const f32x4*)(gate_b + cg0 + bj * HALF + 4 * n);
#pragma unroll
            for (int ai = 0; ai < 2; ++ai)
#pragma unroll
                for (int m = 0; m < 4; ++m) {
                    const int row = row0 + ai * HALF + m * 16;
                    const float rs = row_rstd(ssq, row);
#pragma unroll
                    for (int bj = 0; bj < 2; ++bj) {
                        const f32x4 a = acc[ai][bj][m][0] * rs + gb[bj][0], b = acc[ai][bj][m][1] * rs + gb[bj][1];
                        u32x4 w; w.x = cvt_pk_bf16(fast_sigmoid(a[0]), fast_sigmoid(a[1])); w.y = cvt_pk_bf16(fast_sigmoid(a[2]), fast_sigmoid(a[3]));
                        w.z = cvt_pk_bf16(fast_sigmoid(b[0]), fast_sigmoid(b[1])); w.w = cvt_pk_bf16(fast_sigmoid(b[2]), fast_sigmoid(b[3]));
                        *(u32x4*)(G + (size_t)row * 3072 + cg0 + bj * HALF) = w;
                        if (PROBE_G && pn >= 18) { float* xo = xprobe + (size_t)row * D + cg0 - 2048 + bj * HALF; *(f32x4*)xo = (f32x4){bf_lo(w.x), bf_hi(w.x), bf_lo(w.y), bf_hi(w.y)}; *(f32x4*)(xo + 4) = (f32x4){bf_lo(w.z), bf_hi(w.z), bf_lo(w.w), bf_hi(w.w)}; }
                    }
                    asm volatile("" ::: "memory");
                }
        }
    }
};

struct EpiBranch {
    static constexpr bool HAS_MID = !PROBE_NOG;
    const bf16_t* G; bf16_t* MB; float* xprobe; SplitK sk;
    __device__ __forceinline__ void mid(Acc& acc, const Unit& u, int t, int wr, int wc, int fr, int fq) const {
        asm volatile("" : "+v"(fr), "+v"(fq));
        const int row0 = u.pm * BM + wr * 64 + fr, col0 = u.pn * BM + wc * 32 + 8 * fq + (t == 8 ? 0 : 1024);
#pragma unroll
        for (int ai = 0; ai < 2; ++ai)
#pragma unroll
            for (int m = 0; m < 4; ++m) {
                const bf16_t* gp = G + (size_t)(row0 + ai * HALF + m * 16) * 3072 + col0;
#pragma unroll
                for (int bj = 0; bj < 2; ++bj) {
                    const u32x4 ga = *(const u32x4*)(gp + bj * HALF), gb = *(const u32x4*)(gp + bj * HALF + 1024);
                    f32x4 r0, r1;
                    r0[0] = bf_lo(ga.x) * __builtin_amdgcn_rcpf(bf_lo(gb.x)); r0[1] = bf_hi(ga.x) * __builtin_amdgcn_rcpf(bf_hi(gb.x));
                    r0[2] = bf_lo(ga.y) * __builtin_amdgcn_rcpf(bf_lo(gb.y)); r0[3] = bf_hi(ga.y) * __builtin_amdgcn_rcpf(bf_hi(gb.y));
                    r1[0] = bf_lo(ga.z) * __builtin_amdgcn_rcpf(bf_lo(gb.z)); r1[1] = bf_hi(ga.z) * __builtin_amdgcn_rcpf(bf_hi(gb.z));
                    r1[2] = bf_lo(ga.w) * __builtin_amdgcn_rcpf(bf_lo(gb.w)); r1[3] = bf_hi(ga.w) * __builtin_amdgcn_rcpf(bf_hi(gb.w));
                    acc[ai][bj][m][0] *= r0; acc[ai][bj][m][1] *= r1;
                }
                asm volatile("" ::: "memory");
            }
    }
    __device__ __forceinline__ void operator()(Acc& acc, const Unit& u, int wr, int wc, int fr, int fq, LAS unsigned char* lds) const {
        const int row0 = u.pm * BM + wr * 64 + fr, col0 = u.pn * BM + wc * 32 + 8 * fq;
        if (u.ks >= 0) {
            const int wid = wr * 4 + wc, lane = fq * 16 + fr, tile = (u.pm - 64) + 2 * u.pn;
            sk.exchange(acc, u, wid, lane);
#pragma unroll
            for (int pp = 0; pp < 2; ++pp) {
                const int pair = u.ks * 2 + pp, ai = pair >> 2, m = pair & 3, row = row0 + ai * HALF + m * 16;
                const bf16_t* gp = G + (size_t)row * 3072 + col0;
#pragma unroll
                for (int bj = 0; bj < 2; ++bj) {
                    const u32x4 g0 = *(const u32x4*)(gp + bj * HALF), g1 = *(const u32x4*)(gp + bj * HALF + 1024), g2 = *(const u32x4*)(gp + bj * HALF + 2048);
                    const int q0 = ((ai * 2 + bj) * 4 + m) * 2;
                    const f32x4 a0 = sk.part(tile, 0, wid, lane, q0) + sk.part(tile, 1, wid, lane, q0), a1 = sk.part(tile, 2, wid, lane, q0), a2 = sk.part(tile, 3, wid, lane, q0);
                    const f32x4 b0 = sk.part(tile, 0, wid, lane, q0 + 1) + sk.part(tile, 1, wid, lane, q0 + 1), b1 = sk.part(tile, 2, wid, lane, q0 + 1), b2 = sk.part(tile, 3, wid, lane, q0 + 1);
                    u32x4 w;
                    w.x = cvt_pk_bf16(bf_lo(g0.x) * a0[0] + bf_lo(g1.x) * a1[0] + bf_lo(g2.x) * a2[0], bf_hi(g0.x) * a0[1] + bf_hi(g1.x) * a1[1] + bf_hi(g2.x) * a2[1]);
                    w.y = cvt_pk_bf16(bf_lo(g0.y) * a0[2] + bf_lo(g1.y) * a1[2] + bf_lo(g2.y) * a2[2], bf_hi(g0.y) * a0[3] + bf_hi(g1.y) * a1[3] + bf_hi(g2.y) * a2[3]);
                    w.z = cvt_pk_bf16(bf_lo(g0.z) * b0[0] + bf_lo(g1.z) * b1[0] + bf_lo(g2.z) * b2[0], bf_hi(g0.z) * b0[1] + bf_hi(g1.z) * b1[1] + bf_hi(g2.z) * b2[1]);
                    w.w = cvt_pk_bf16(bf_lo(g0.w) * b0[2] + bf_lo(g1.w) * b1[2] + bf_lo(g2.w) * b2[2], bf_hi(g0.w) * b0[3] + bf_hi(g1.w) * b1[3] + bf_hi(g2.w) * b2[3]);
                    *(u32x4*)(MB + (size_t)row * D + col0 + bj * HALF) = w;
                }
            }
            return;
        }
#pragma unroll
        for (int ai = 0; ai < 2; ++ai)
#pragma unroll
            for (int m = 0; m < 4; ++m) {
                const int row = row0 + ai * HALF + m * 16;
#pragma unroll
                for (int bj = 0; bj < 2; ++bj) {
                    u32x4 gc = *(const u32x4*)(G + (size_t)row * 3072 + 2048 + col0 + bj * HALF); if (PROBE_NOG) gc = (u32x4){0x3f803f80u, 0x3f803f80u, 0x3f803f80u, 0x3f803f80u};
                    const f32x4 a = acc[ai][bj][m][0], b = acc[ai][bj][m][1];
                    u32x4 w; w.x = cvt_pk_bf16(a[0] * bf_lo(gc.x), a[1] * bf_hi(gc.x)); w.y = cvt_pk_bf16(a[2] * bf_lo(gc.y), a[3] * bf_hi(gc.y));
                    w.z = cvt_pk_bf16(b[0] * bf_lo(gc.z), b[1] * bf_hi(gc.z)); w.w = cvt_pk_bf16(b[2] * bf_lo(gc.w), b[3] * bf_hi(gc.w));
                    *(u32x4*)(MB + (size_t)row * D + col0 + bj * HALF) = w;
                    if (PROBE_M) { float* xo = xprobe + (size_t)row * D + col0 + bj * HALF; *(f32x4*)xo = (f32x4){a[0] * bf_lo(gc.x), a[1] * bf_hi(gc.x), a[2] * bf_lo(gc.y), a[3] * bf_hi(gc.y)}; *(f32x4*)(xo + 4) = (f32x4){b[0] * bf_lo(gc.z), b[1] * bf_hi(gc.z), b[2] * bf_lo(gc.w), b[3] * bf_hi(gc.w)}; }
                }
                asm volatile("" ::: "memory");
            }
    }
};
}

__device__ __forceinline__ float wave_sum(float v) {
#pragma unroll
    for (int o = 1; o < 64; o <<= 1) v += __shfl_xor(v, o);
    return v;
}
__device__ __forceinline__ void tr_item(const float* W, int ldw, int k0s, int c0s, const float* ksc, bf16_t* WT, int ldt, int r0d, int k0d, LAS float* scr, int lane) {
    f32x4 ld[8];
#pragma unroll
    for (int i = 0; i < 8; ++i) ld[i] = *(const f32x4*)(W + (size_t)(k0s + 8 * i + (lane >> 3)) * ldw + c0s + 4 * (lane & 7));
#pragma unroll
    for (int i = 0; i < 8; ++i) { const int kk = 8 * i + (lane >> 3); f32x4 v = ld[i]; if (ksc) v *= ksc[k0s + kk];
        LAS float* d = scr + kk * 33 + 4 * (lane & 7); d[0] = v[0]; d[1] = v[1]; d[2] = v[2]; d[3] = v[3]; }
    asm volatile("s_waitcnt lgkmcnt(0)" ::: "memory");
    const int c = lane & 7;
#pragma unroll
    for (int j = 0; j < 4; ++j) { const int n = (lane >> 3) + 8 * j; const LAS float* s = scr + (8 * c) * 33 + n;
        u32x4 o; o.x = cvt_pk_bf16(s[0 * 33], s[1 * 33]); o.y = cvt_pk_bf16(s[2 * 33], s[3 * 33]); o.z = cvt_pk_bf16(s[4 * 33], s[5 * 33]); o.w = cvt_pk_bf16(s[6 * 33], s[7 * 33]);
        *(u32x4*)(WT + (size_t)(r0d + n) * ldt + k0d + 8 * c) = o; }
    asm volatile("s_waitcnt lgkmcnt(0)" ::: "memory");
}
__device__ __forceinline__ void fold_pool_item(const float* pw, const float* psc, const float* Wp, int c0, bf16_t* WT, int k0d, LAS float* scr, int lane) {
    const int n = lane & 31, hf = lane >> 5;
    float wp[64];
#pragma unroll
    for (int e = 0; e < 64; ++e) wp[e] = Wp[(size_t)e * D + c0 + n] * psc[e];
    for (int cc = hf * 32; cc < hf * 32 + 32; ++cc) {
        const f32x4* pr = (const f32x4*)(pw + cc * 64); float acc = 0.f;
#pragma unroll
        for (int q = 0; q < 16; ++q) { const f32x4 p4 = pr[q]; acc += p4[0] * wp[4 * q] + p4[1] * wp[4 * q + 1] + p4[2] * wp[4 * q + 2] + p4[3] * wp[4 * q + 3]; }
        scr[cc * 33 + n] = acc;
    }
    asm volatile("s_waitcnt lgkmcnt(0)" ::: "memory");
    const int c = lane & 7;
#pragma unroll
    for (int j = 0; j < 4; ++j) { const int nn = (lane >> 3) + 8 * j; const LAS float* sx = scr + (8 * c) * 33 + nn;
        u32x4 o; o.x = cvt_pk_bf16(sx[0 * 33], sx[1 * 33]); o.y = cvt_pk_bf16(sx[2 * 33], sx[3 * 33]); o.z = cvt_pk_bf16(sx[4 * 33], sx[5 * 33]); o.w = cvt_pk_bf16(sx[6 * 33], sx[7 * 33]);
        *(u32x4*)(WT + (size_t)(c0 + nn) * D + k0d + 8 * c) = o; }
    asm volatile("s_waitcnt lgkmcnt(0)" ::: "memory");
}
__device__ __forceinline__ int mixcol(int c) {
    const int pn = c >> 8, cc = c & 255, bj = cc >> 7, wc = (cc >> 5) & 3;
    if (pn < 4) return pn * 256 + wc * 64 + bj * 32;
    if (pn == 7 || pn == 8) return (bj ? 2304 : 1792) + (pn - 7) * 128 + (cc & 127);
    if (pn == 9) return 2048 + cc;
    return c;
}
__device__ __forceinline__ void prologue(const Args& a, LAS unsigned char* lds, int bid, int gdim) {
    int tid_ = threadIdx.x; asm volatile("" : "+v"(tid_));
    const int tid = tid_, lane = tid & 63, wave = tid >> 6;
    LAS float* scr = (LAS float*)(lds + wave * 16384);
    const int gw = bid * 8 + wave, NGW = gdim * 8;
    constexpr int PER_LAYER = 12288;
    for (int it = gw; it < DEPTH * PER_LAYER; it += NGW) {
        const int itr = DEPTH * PER_LAYER - 1 - it;
        const int l = itr / PER_LAYER; int r = itr % PER_LAYER;
        bf16_t* WL = (bf16_t*)(a.ws + WS_W) + (size_t)l * LAYER_W_ELEMS;
        if (r < 2816) { const int kb = r / 176, c = (r % 176) * 32; const int src = ((c >> 7) & 1) * FF + (c >> 8) * 128 + (c & 127);
            tr_item(a.in[7] + (size_t)l * D * NIN, NIN, kb * 64, src, a.in[6] + l * D, WL + W_1IN, D, c, kb * 64, scr, lane); continue; }
        r -= 2816;
        if (r < 1408) { const int kb = r / 32, c = (r % 32) * 32; tr_item(a.in[8] + (size_t)l * FF * D, D, kb * 64, c, nullptr, WL + W_1OUT, FF, c, kb * 64, scr, lane); continue; }
        r -= 1408;
        if (r < 2816) { const int kb = r / 176, c = (r % 176) * 32; tr_item(a.in[10] + (size_t)l * D * NIN, NIN, kb * 64, mixcol(c), a.in[9] + l * D, WL + W_MIX, D, c, kb * 64, scr, lane); continue; }
        r -= 2816;
        if (r < 512) {
            if (r < 256) { const int kb = r / 32, c = (r % 32) * 32; tr_item(a.in[19] + (size_t)l * 512 * D, D, kb * 64, c, nullptr, WL + W_BR, D, c, kb * 64, scr, lane); }
            else if (r < 384) { r -= 256; fold_pool_item(a.in[15] + (size_t)(l * 4 + r / 32) * 4096, a.in[16] + l * 256 + (r / 32) * 64, a.in[20] + (size_t)l * 256 * D + (size_t)(r / 32) * 64 * D, (r % 32) * 32, WL + W_BR, 512 + (r / 32) * 64, scr, lane); }
            else { r -= 384; const int kb = r / 32, c = (r % 32) * 32; tr_item(a.in[21] + (size_t)l * 256 * D, D, kb * 64, c, nullptr, WL + W_BR, D, c, 768 + kb * 64, scr, lane); }
            continue; }
        r -= 512;
        if (r < 512) { const int kb = r / 32, c = (r % 32) * 32; tr_item(a.in[22] + (size_t)l * D * D, D, kb * 64, c, nullptr, WL + W_O, D, c, kb * 64, scr, lane); continue; }
        r -= 512;
        if (r < 2816) { const int kb = r / 176, c = (r % 176) * 32; const int src = ((c >> 7) & 1) * FF + (c >> 8) * 128 + (c & 127);
            tr_item(a.in[24] + (size_t)l * D * NIN, NIN, kb * 64, src, a.in[23] + l * D, WL + W_2IN, D, c, kb * 64, scr, lane); continue; }
        r -= 2816;
        { const int kb = r / 32, c = (r % 32) * 32; tr_item(a.in[25] + (size_t)l * FF * D, D, kb * 64, c, nullptr, WL + W_2OUT, FF, c, kb * 64, scr, lane); }
    }
    float* ssq = (float*)(a.ws + WS_SSQ); bf16_t* XB = (bf16_t*)(a.ws + WS_XB);
    for (int row = gw; row < T; row += NGW) {
        const float* src = row < TP ? a.in[0] + (size_t)row * D : a.in[1] + (size_t)(row - TP) * D;
        float s = 0.f;
#pragma unroll
        for (int j = 0; j < 4; ++j) { const f32x4 v = *(const f32x4*)(src + 4 * lane + 256 * j); s += (v[0] * v[0] + v[1] * v[1]) + (v[2] * v[2] + v[3] * v[3]);
            u32x2 w; w.x = cvt_pk_bf16(v[0], v[1]); w.y = cvt_pk_bf16(v[2], v[3]); *(u32x2*)(XB + (size_t)row * D + 4 * lane + 256 * j) = w; }
        s = wave_sum(s);
        if (lane < 16) ssq[(size_t)row * 16 + lane] = lane == 0 ? s : 0.f;
    }
}

#define LDS_SYNC() do { asm volatile("s_waitcnt lgkmcnt(0)" ::: "memory"); __builtin_amdgcn_s_barrier(); asm volatile("" ::: "memory"); } while (0)
constexpr int KS_STRIDE = 72, VT_STRIDE = 68;
constexpr int ATT_KS = 0, ATT_VT = 2 * 64 * KS_STRIDE * 2, ATT_BIAS = ATT_VT + 2 * 64 * VT_STRIDE * 2;

template <bool SAMPLE>
__device__ __forceinline__ void attn_unit(const Args& a, LAS unsigned char* lds, int l, int ux) {
    int tid_ = threadIdx.x; asm volatile("" : "+v"(tid_));
    const int tid = tid_, lane = tid & 63, wave = __builtin_amdgcn_readfirstlane(tid >> 6), hl = wave >> 2, qb = wave & 3, fr = lane & 15, fq = lane >> 4;
    const bf16_t* Q = (const bf16_t*)(a.ws + WS_Q); const bf16_t* Kb = (const bf16_t*)(a.ws + WS_K); const bf16_t* Vb = (const bf16_t*)(a.ws + WS_V);
    bf16_t* OC = (bf16_t*)(a.ws + WS_OC);
    const int hp = ux & 3, cb = ux >> 2;
    const int qrow0 = SAMPLE ? TP + cb * SL : cb * 64;
    const int first = SAMPLE ? 0 : (cb < 8 ? 8 - cb : 0);
    const bool active = SAMPLE ? (qb == 0) : true;
    const int h = hp * 2 + hl;
    LAS bf16_t* Ks = (LAS bf16_t*)(lds + ATT_KS); LAS bf16_t* Vt = (LAS bf16_t*)(lds + ATT_VT); LAS float* Bs = (LAS float*)(lds + ATT_BIAS);
    const float* ck = a.in[2] + ((size_t)(l * NBATCH + cb) * RC) * 512; const float* cv = a.in[3] + ((size_t)(l * NBATCH + cb) * RC) * 512;

    LDS_SYNC();
    for (int i = tid; i < 514; i += 512) { const int hh = i / 257, j = i % 257; Bs[hh * 260 + j] = a.in[14][(size_t)(l * 8 + hp * 2 + hh) * 257 + j]; }
    bf16x8 qf[2];
    if (active) {
        const bf16_t* qp = Q + (size_t)(qrow0 + qb * 16 + fr) * 512 + h * 64 + 8 * fq;
        qf[0] = *(const bf16x8*)qp; qf[1] = *(const bf16x8*)(qp + 32);
    }
    f32x4 o[4]; float mrun = -1e30f, lrun = 0.f;
#pragma unroll
    for (int i = 0; i < 4; ++i) o[i] = (f32x4){0.f, 0.f, 0.f, 0.f};

    u32x4 kr[2], vr[2]; f32x4 kf[2][2], vf[2][2];
    auto issue = [&](int ti) {
        if (SAMPLE && ti < 8) {
#pragma unroll
            for (int p = 0; p < 2; ++p) {
                const int idx = tid + p * 512, key = idx >> 4, seg = idx & 15;
                const float* s = ck + (size_t)(ti * 64 + key) * 512 + hp * 128 + seg * 8; kf[p][0] = *(const f32x4*)s; kf[p][1] = *(const f32x4*)(s + 4);
                const int sv = wave + 8 * p; const float* s2 = cv + (size_t)(ti * 64 + lane) * 512 + hp * 128 + sv * 8; vf[p][0] = *(const f32x4*)s2; vf[p][1] = *(const f32x4*)(s2 + 4);
            }
        } else {
            const int tok0 = SAMPLE ? qrow0 : (cb - 8 + ti) * 64;
#pragma unroll
            for (int p = 0; p < 2; ++p) {
                const int idx = tid + p * 512, key = idx >> 4, seg = idx & 15;
                const bool okk = !SAMPLE || key < SL, okv = !SAMPLE || lane < SL;
                kr[p] = okk ? *(const u32x4*)(Kb + (size_t)(tok0 + key) * 512 + hp * 128 + seg * 8) : (u32x4){0u, 0u, 0u, 0u};
                const int sv = wave + 8 * p;
                vr[p] = okv ? *(const u32x4*)(Vb + (size_t)(tok0 + lane) * 512 + hp * 128 + sv * 8) : (u32x4){0u, 0u, 0u, 0u};
            }
        }
    };
    auto commit = [&](int ti) {
        if (SAMPLE && ti < 8) {
#pragma unroll
            for (int p = 0; p < 2; ++p) {
                kr[p].x = cvt_pk_bf16(kf[p][0][0], kf[p][0][1]); kr[p].y = cvt_pk_bf16(kf[p][0][2], kf[p][0][3]); kr[p].z = cvt_pk_bf16(kf[p][1][0], kf[p][1][1]); kr[p].w = cvt_pk_bf16(kf[p][1][2], kf[p][1][3]);
                vr[p].x = cvt_pk_bf16(vf[p][0][0], vf[p][0][1]); vr[p].y = cvt_pk_bf16(vf[p][0][2], vf[p][0][3]); vr[p].z = cvt_pk_bf16(vf[p][1][0], vf[p][1][1]); vr[p].w = cvt_pk_bf16(vf[p][1][2], vf[p][1][3]);
            }
        }
#pragma unroll
        for (int p = 0; p < 2; ++p) {
            const int idx = tid + p * 512, key = idx >> 4, seg = idx & 15;
            *(LAS u32x4*)(Ks + ((seg >> 3) * 64 + key) * KS_STRIDE + (seg & 7) * 8) = kr[p];
            const int sv = wave + 8 * p; LAS bf16_t* vp = Vt + ((sv >> 3) * 64 + (sv & 7) * 8) * VT_STRIDE + lane;
            vp[0 * VT_STRIDE] = (bf16_t)(vr[p].x & 0xffffu); vp[1 * VT_STRIDE] = (bf16_t)(vr[p].x >> 16);
            vp[2 * VT_STRIDE] = (bf16_t)(vr[p].y & 0xffffu); vp[3 * VT_STRIDE] = (bf16_t)(vr[p].y >> 16);
            vp[4 * VT_STRIDE] = (bf16_t)(vr[p].z & 0xffffu); vp[5 * VT_STRIDE] = (bf16_t)(vr[p].z >> 16);
            vp[6 * VT_STRIDE] = (bf16_t)(vr[p].w & 0xffffu); vp[7 * VT_STRIDE] = (bf16_t)(vr[p].w >> 16);
        }
    };

    issue(first);
    for (int ti = first; ti <= 8; ++ti) {
        commit(ti);
        LDS_SYNC();
        if (ti < 8) issue(ti + 1);
        if (active) {
            f32x4 s[4];
#pragma unroll
            for (int kt = 0; kt < 4; ++kt) {
                s[kt] = (f32x4){0.f, 0.f, 0.f, 0.f};
#pragma unroll
                for (int ks = 0; ks < 2; ++ks) {
                    const bf16x8 ka = *(const LAS bf16x8*)(Ks + (hl * 64 + kt * 16 + fr) * KS_STRIDE + ks * 32 + 8 * fq);
                    s[kt] = __builtin_amdgcn_mfma_f32_16x16x32_bf16(ka, qf[ks], s[kt], 0, 0, 0);
                }
            }
            const int qoff = qb * 16 + fr; float mx = -1e30f;
            if (ti >= 6) {
#pragma unroll
                for (int kt = 0; kt < 4; ++kt)
#pragma unroll
                    for (int i = 0; i < 4; ++i) {
                        const int kk = kt * 16 + 4 * fq + i; int rel = (ti - 8) * 64 + kk - qoff; rel = rel < -128 ? -128 : (rel > 128 ? 128 : rel);
                        float v = s[kt][i] * 0.125f + Bs[hl * 260 + rel + 128];
                        if (SAMPLE && ti == 8 && kk >= SL) v = -1e30f;
                        s[kt][i] = v; mx = fmaxf(mx, v);
                    }
            } else {
                const float b0 = Bs[hl * 260];
#pragma unroll
                for (int kt = 0; kt < 4; ++kt)
#pragma unroll
                    for (int i = 0; i < 4; ++i) { const float v = s[kt][i] * 0.125f + b0; s[kt][i] = v; mx = fmaxf(mx, v); }
            }
            mx = fmaxf(mx, __shfl_xor(mx, 16)); mx = fmaxf(mx, __shfl_xor(mx, 32));
            const float mnew = fmaxf(mrun, mx), alpha = __expf(mrun - mnew); mrun = mnew;
            float ps = 0.f;
#pragma unroll
            for (int kt = 0; kt < 4; ++kt)
#pragma unroll
                for (int i = 0; i < 4; ++i) { const float p = __expf(s[kt][i] - mnew); s[kt][i] = p; ps += p; }
            lrun = lrun * alpha + ps;
#pragma unroll
            for (int db = 0; db < 4; ++db) o[db] *= alpha;
            bf16x8 pb[2];
#pragma unroll
            for (int kp = 0; kp < 2; ++kp) {
                u32x4 w; w.x = cvt_pk_bf16(s[2 * kp][0], s[2 * kp][1]); w.y = cvt_pk_bf16(s[2 * kp][2], s[2 * kp][3]);
                w.z = cvt_pk_bf16(s[2 * kp + 1][0], s[2 * kp + 1][1]); w.w = cvt_pk_bf16(s[2 * kp + 1][2], s[2 * kp + 1][3]);
                pb[kp] = __builtin_bit_cast(bf16x8, w);
            }
#pragma unroll
            for (int db = 0; db < 4; ++db)
#pragma unroll
                for (int kp = 0; kp < 2; ++kp) {
                    const LAS bf16_t* vp = Vt + (hl * 64 + db * 16 + fr) * VT_STRIDE + kp * 32 + 4 * fq;
                    const u32x2 v0 = *(const LAS u32x2*)vp, v1 = *(const LAS u32x2*)(vp + 16);
                    u32x4 w; w.x = v0.x; w.y = v0.y; w.z = v1.x; w.w = v1.y;
                    o[db] = __builtin_amdgcn_mfma_f32_16x16x32_bf16(__builtin_bit_cast(bf16x8, w), pb[kp], o[db], 0, 0, 0);
                }
        }
        LDS_SYNC();
    }
    if (active) {
        lrun += __shfl_xor(lrun, 16); lrun += __shfl_xor(lrun, 32);
        const float inv = 1.0f / lrun;
        bf16_t* op = OC + (size_t)(qrow0 + qb * 16 + fr) * D + h * 64 + 4 * fq;
#pragma unroll
        for (int db = 0; db < 4; ++db) { u32x2 w; w.x = cvt_pk_bf16(o[db][0] * inv, o[db][1] * inv); w.y = cvt_pk_bf16(o[db][2] * inv, o[db][3] * inv); *(u32x2*)(op + db * 16) = w; }
    }
}


template <int DB> __device__ __forceinline__ void tr_read4(unsigned addr, u32x2& r0, u32x2& r1, u32x2& r2, u32x2& r3) {
    asm volatile("ds_read_b64_tr_b16 %0, %4 offset:%5\n\tds_read_b64_tr_b16 %1, %4 offset:%6\n\tds_read_b64_tr_b16 %2, %4 offset:%7\n\tds_read_b64_tr_b16 %3, %4 offset:%8\n\ts_waitcnt lgkmcnt(0)"
                 : "=&v"(r0), "=&v"(r1), "=&v"(r2), "=&v"(r3)
                 : "v"(addr), "n"(DB * 32), "n"(DB * 32 + 16 * 144), "n"(DB * 32 + 32 * 144), "n"(DB * 32 + 48 * 144) : "memory");
}

constexpr int PKV_STRIDE = 72, PBUF_BYTES = 2 * (2 * 64 * PKV_STRIDE * 2), PATT_BIAS = 2 * PBUF_BYTES;
__device__ __forceinline__ void attn_unit_p(const Args& a, LAS unsigned char* lds, int l, int ux) {
    int tid_ = threadIdx.x; asm volatile("" : "+v"(tid_));
    const int tid = tid_, lane = tid & 63, wave = __builtin_amdgcn_readfirstlane(tid >> 6), hl = wave >> 2, qb = wave & 3, fr = lane & 15, fq = lane >> 4;
    const bf16_t* Q = (const bf16_t*)(a.ws + WS_Q); const bf16_t* Kb = (const bf16_t*)(a.ws + WS_K); const bf16_t* Vb = (const bf16_t*)(a.ws + WS_V);
    bf16_t* OC = (bf16_t*)(a.ws + WS_OC);
    const int hp = ux & 3, cb = ux >> 2, qrow0 = cb * 64, first = cb < 8 ? 8 - cb : 0, h = hp * 2 + hl;
    LAS float* Bs = (LAS float*)(lds + PATT_BIAS);
    LDS_SYNC();
    for (int i = tid; i < 514; i += 512) { const int hh = i / 257, j = i % 257; Bs[hh * 260 + j] = a.in[14][(size_t)(l * 8 + hp * 2 + hh) * 257 + j]; }
    bf16x8 qf[2];
    { const bf16_t* qp = Q + (size_t)(qrow0 + qb * 16 + fr) * 512 + h * 64 + 8 * fq; qf[0] = *(const bf16x8*)qp; qf[1] = *(const bf16x8*)(qp + 32); }
    f32x4 o[4]; float mrun = -1e30f, lrun = 0.f;
#pragma unroll
    for (int i = 0; i < 4; ++i) o[i] = (f32x4){0.f, 0.f, 0.f, 0.f};
    u32x4 kr[2], vr[2];
#define PA_ISSUE(ti) do { const int cix_ = cb - 8 + (ti); _Pragma("unroll") for (int p = 0; p < 2; ++p) { const int idx = tid + p * 512; \
        kr[p] = *(const u32x4*)(Kb + (size_t)(cix_ * 64 + (idx >> 4)) * 512 + hp * 128 + (idx & 15) * 8); \
        vr[p] = *(const u32x4*)(Vb + (size_t)(cix_ * 64 + (idx >> 4)) * 512 + hp * 128 + (idx & 15) * 8); } } while (0)
#define PA_COMMIT(bufb) do { LAS bf16_t* Ks_ = (LAS bf16_t*)(lds + (bufb) * PBUF_BYTES); LAS bf16_t* Vt_ = Ks_ + 2 * 64 * PKV_STRIDE; \
        _Pragma("unroll") for (int p = 0; p < 2; ++p) { const int idx = tid + p * 512; \
        *(LAS u32x4*)(Ks_ + (((idx & 15) >> 3) * 64 + (idx >> 4)) * PKV_STRIDE + (idx & 7) * 8) = kr[p]; \
        *(LAS u32x4*)(Vt_ + (((idx & 15) >> 3) * 64 + (idx >> 4)) * PKV_STRIDE + (idx & 7) * 8) = vr[p]; } } while (0)
    PA_ISSUE(first); PA_COMMIT(0);
    if (first < 8) PA_ISSUE(first + 1);
    LDS_SYNC();
    for (int ti = first; ti <= 8; ++ti) {
        const int bsel = (ti - first) & 1;
        const LAS bf16_t* Ks = (const LAS bf16_t*)(lds + bsel * PBUF_BYTES); const LAS bf16_t* Vt = Ks + 2 * 64 * PKV_STRIDE;
        f32x4 s[4];
#pragma unroll
        for (int kt = 0; kt < 4; ++kt) {
            s[kt] = (f32x4){0.f, 0.f, 0.f, 0.f};
#pragma unroll
            for (int ks = 0; ks < 2; ++ks) {
                const bf16x8 ka = *(const LAS bf16x8*)(Ks + (hl * 64 + kt * 16 + fr) * PKV_STRIDE + ks * 32 + 8 * fq);
                s[kt] = __builtin_amdgcn_mfma_f32_16x16x32_bf16(ka, qf[ks], s[kt], 0, 0, 0);
            }
        }
        const int qoff = qb * 16 + fr; float mx = -1e30f;
        if (ti >= 6) {
#pragma unroll
            for (int kt = 0; kt < 4; ++kt)
#pragma unroll
                for (int i = 0; i < 4; ++i) {
                    const int kk = kt * 16 + 4 * fq + i; int rel = (ti - 8) * 64 + kk - qoff; rel = rel < -128 ? -128 : (rel > 128 ? 128 : rel);
                    const float v = s[kt][i] * 0.125f + Bs[hl * 260 + rel + 128];
                    s[kt][i] = v; mx = fmaxf(mx, v);
                }
        } else {
            const float b0 = Bs[hl * 260];
#pragma unroll
            for (int kt = 0; kt < 4; ++kt)
#pragma unroll
                for (int i = 0; i < 4; ++i) { const float v = s[kt][i] * 0.125f + b0; s[kt][i] = v; mx = fmaxf(mx, v); }
        }
        mx = fmaxf(mx, __shfl_xor(mx, 16)); mx = fmaxf(mx, __shfl_xor(mx, 32));
        const float mnew = fmaxf(mrun, mx), alpha = __expf(mrun - mnew); mrun = mnew;
        float ps = 0.f;
#pragma unroll
        for (int kt = 0; kt < 4; ++kt)
#pragma unroll
            for (int i = 0; i < 4; ++i) { const float p = __expf(s[kt][i] - mnew); s[kt][i] = p; ps += p; }
        lrun = lrun * alpha + ps;
#pragma unroll
        for (int db = 0; db < 4; ++db) o[db] *= alpha;
        bf16x8 pb[2];
#pragma unroll
        for (int kp = 0; kp < 2; ++kp) {
            u32x4 w; w.x = cvt_pk_bf16(s[2 * kp][0], s[2 * kp][1]); w.y = cvt_pk_bf16(s[2 * kp][2], s[2 * kp][3]);
            w.z = cvt_pk_bf16(s[2 * kp + 1][0], s[2 * kp + 1][1]); w.w = cvt_pk_bf16(s[2 * kp + 1][2], s[2 * kp + 1][3]);
            pb[kp] = __builtin_bit_cast(bf16x8, w);
        }
        {
            const unsigned vaddr = (unsigned)(size_t)(Vt + (hl * 64 + 4 * fq + (fr >> 2)) * PKV_STRIDE + 4 * (fr & 3));
            u32x2 r0, r1, r2, r3; u32x4 w;
            tr_read4<0>(vaddr, r0, r1, r2, r3);
            w.x = r0.x; w.y = r0.y; w.z = r1.x; w.w = r1.y; o[0] = __builtin_amdgcn_mfma_f32_16x16x32_bf16(__builtin_bit_cast(bf16x8, w), pb[0], o[0], 0, 0, 0);
            w.x = r2.x; w.y = r2.y; w.z = r3.x; w.w = r3.y; o[0] = __builtin_amdgcn_mfma_f32_16x16x32_bf16(__builtin_bit_cast(bf16x8, w), pb[1], o[0], 0, 0, 0);
            tr_read4<1>(vaddr, r0, r1, r2, r3);
            w.x = r0.x; w.y = r0.y; w.z = r1.x; w.w = r1.y; o[1] = __builtin_amdgcn_mfma_f32_16x16x32_bf16(__builtin_bit_cast(bf16x8, w), pb[0], o[1], 0, 0, 0);
            w.x = r2.x; w.y = r2.y; w.z = r3.x; w.w = r3.y; o[1] = __builtin_amdgcn_mfma_f32_16x16x32_bf16(__builtin_bit_cast(bf16x8, w), pb[1], o[1], 0, 0, 0);
            tr_read4<2>(vaddr, r0, r1, r2, r3);
            w.x = r0.x; w.y = r0.y; w.z = r1.x; w.w = r1.y; o[2] = __builtin_amdgcn_mfma_f32_16x16x32_bf16(__builtin_bit_cast(bf16x8, w), pb[0], o[2], 0, 0, 0);
            w.x = r2.x; w.y = r2.y; w.z = r3.x; w.w = r3.y; o[2] = __builtin_amdgcn_mfma_f32_16x16x32_bf16(__builtin_bit_cast(bf16x8, w), pb[1], o[2], 0, 0, 0);
            tr_read4<3>(vaddr, r0, r1, r2, r3);
            w.x = r0.x; w.y = r0.y; w.z = r1.x; w.w = r1.y; o[3] = __builtin_amdgcn_mfma_f32_16x16x32_bf16(__builtin_bit_cast(bf16x8, w), pb[0], o[3], 0, 0, 0);
            w.x = r2.x; w.y = r2.y; w.z = r3.x; w.w = r3.y; o[3] = __builtin_amdgcn_mfma_f32_16x16x32_bf16(__builtin_bit_cast(bf16x8, w), pb[1], o[3], 0, 0, 0);
        }
        if (ti < 8) { PA_COMMIT(bsel ^ 1); if (ti < 7) PA_ISSUE(ti + 2); }
        LDS_SYNC();
    }
#undef PA_ISSUE
#undef PA_COMMIT
    lrun += __shfl_xor(lrun, 16); lrun += __shfl_xor(lrun, 32);
    const float inv = 1.0f / lrun;
    bf16_t* op = OC + (size_t)(qrow0 + qb * 16 + fr) * D + h * 64 + 4 * fq;
#pragma unroll
    for (int db = 0; db < 4; ++db) { u32x2 w; w.x = cvt_pk_bf16(o[db][0] * inv, o[db][1] * inv); w.y = cvt_pk_bf16(o[db][2] * inv, o[db][3] * inv); *(u32x2*)(op + db * 16) = w; }
}

__device__ __forceinline__ void attn_unit_s(const Args& a, LAS unsigned char* lds, int l, int ux) {
    int tid_ = threadIdx.x; asm volatile("" : "+v"(tid_));
    const int tid = tid_, lane = tid & 63, wave = __builtin_amdgcn_readfirstlane(tid >> 6), fr = lane & 15, fq = lane >> 4;
    const bf16_t* Q = (const bf16_t*)(a.ws + WS_Q); const bf16_t* Kb = (const bf16_t*)(a.ws + WS_K); const bf16_t* Vb = (const bf16_t*)(a.ws + WS_V);
    bf16_t* OC = (bf16_t*)(a.ws + WS_OC);
    const int h = ux & 7, b = ux >> 3, qrow0 = TP + b * SL;
    const bool active = wave == 0;
    LAS float* Bs = (LAS float*)(lds + PATT_BIAS);
    const float* ck = a.in[2] + ((size_t)(l * NBATCH + b) * RC) * 512 + h * 64; const float* cv = a.in[3] + ((size_t)(l * NBATCH + b) * RC) * 512 + h * 64;
    LDS_SYNC();
    for (int i = tid; i < 257; i += 512) Bs[i] = a.in[14][(size_t)(l * 8 + h) * 257 + i];
    bf16x8 qf[2];
    if (active) { const bf16_t* qp = Q + (size_t)(qrow0 + fr) * 512 + h * 64 + 8 * fq; qf[0] = *(const bf16x8*)qp; qf[1] = *(const bf16x8*)(qp + 32); }
    f32x4 o[4]; float mrun = -1e30f, lrun = 0.f;
#pragma unroll
    for (int i = 0; i < 4; ++i) o[i] = (f32x4){0.f, 0.f, 0.f, 0.f};
    f32x4 kf[2], vf[2];
#define SA_ISSUE(ti) do { _Pragma("unroll") for (int p = 0; p < 2; ++p) { const int idx = tid + p * 512, key = idx >> 4, seg = idx & 15; \
        if ((ti) < 8) { kf[p] = *(const f32x4*)(ck + (size_t)((ti) * 64 + key) * 512 + seg * 4); vf[p] = *(const f32x4*)(cv + (size_t)((ti) * 64 + key) * 512 + seg * 4); } \
        else if (key < SL) { const u32x2 kw = *(const u32x2*)(Kb + (size_t)(qrow0 + key) * 512 + h * 64 + seg * 4), vw = *(const u32x2*)(Vb + (size_t)(qrow0 + key) * 512 + h * 64 + seg * 4); \
            kf[p] = (f32x4){bf_lo(kw.x), bf_hi(kw.x), bf_lo(kw.y), bf_hi(kw.y)}; vf[p] = (f32x4){bf_lo(vw.x), bf_hi(vw.x), bf_lo(vw.y), bf_hi(vw.y)}; } \
        else { kf[p] = (f32x4){0.f, 0.f, 0.f, 0.f}; vf[p] = (f32x4){0.f, 0.f, 0.f, 0.f}; } } } while (0)
#define SA_COMMIT(bufb) do { LAS bf16_t* Ks_ = (LAS bf16_t*)(lds + (bufb) * PBUF_BYTES); LAS bf16_t* Vt_ = Ks_ + 2 * 64 * PKV_STRIDE; \
        _Pragma("unroll") for (int p = 0; p < 2; ++p) { const int idx = tid + p * 512, key = idx >> 4, seg = idx & 15; \
        u32x2 kw; kw.x = cvt_pk_bf16(kf[p][0], kf[p][1]); kw.y = cvt_pk_bf16(kf[p][2], kf[p][3]); *(LAS u32x2*)(Ks_ + key * PKV_STRIDE + seg * 4) = kw; \
        const unsigned v01 = cvt_pk_bf16(vf[p][0], vf[p][1]), v23 = cvt_pk_bf16(vf[p][2], vf[p][3]); LAS bf16_t* vp_ = Vt_ + (seg * 4) * PKV_STRIDE + key; \
        vp_[0] = (bf16_t)(v01 & 0xffffu); vp_[PKV_STRIDE] = (bf16_t)(v01 >> 16); vp_[2 * PKV_STRIDE] = (bf16_t)(v23 & 0xffffu); vp_[3 * PKV_STRIDE] = (bf16_t)(v23 >> 16); } } while (0)
    SA_ISSUE(0); SA_COMMIT(0); SA_ISSUE(1);
    LDS_SYNC();
    for (int ti = 0; ti <= 8; ++ti) {
        const int bsel = ti & 1;
        if (active) {
            const LAS bf16_t* Ks = (const LAS bf16_t*)(lds + bsel * PBUF_BYTES); const LAS bf16_t* Vt = Ks + 2 * 64 * PKV_STRIDE;
            f32x4 s[4];
#pragma unroll
            for (int kt = 0; kt < 4; ++kt) {
                s[kt] = (f32x4){0.f, 0.f, 0.f, 0.f};
#pragma unroll
                for (int ks = 0; ks < 2; ++ks) {
                    const bf16x8 ka = *(const LAS bf16x8*)(Ks + (kt * 16 + fr) * PKV_STRIDE + ks * 32 + 8 * fq);
                    s[kt] = __builtin_amdgcn_mfma_f32_16x16x32_bf16(ka, qf[ks], s[kt], 0, 0, 0);
                }
            }
            float mx = -1e30f;
            if (ti >= 6) {
#pragma unroll
                for (int kt = 0; kt < 4; ++kt)
#pragma unroll
                    for (int i = 0; i < 4; ++i) {
                        const int kk = kt * 16 + 4 * fq + i; int rel = (ti - 8) * 64 + kk - fr; rel = rel < -128 ? -128 : (rel > 128 ? 128 : rel);
                        float v = s[kt][i] * 0.125f + Bs[rel + 128];
                        if (ti == 8 && kk >= SL) v = -1e30f;
                        s[kt][i] = v; mx = fmaxf(mx, v);
                    }
            } else {
                const float b0 = Bs[0];
#pragma unroll
                for (int kt = 0; kt < 4; ++kt)
#pragma unroll
                    for (int i = 0; i < 4; ++i) { const float v = s[kt][i] * 0.125f + b0; s[kt][i] = v; mx = fmaxf(mx, v); }
            }
            mx = fmaxf(mx, __shfl_xor(mx, 16)); mx = fmaxf(mx, __shfl_xor(mx, 32));
            const float mnew = fmaxf(mrun, mx), alpha = __expf(mrun - mnew); mrun = mnew;
            float ps = 0.f;
#pragma unroll
            for (int kt = 0; kt < 4; ++kt)
#pragma unroll
                for (int i = 0; i < 4; ++i) { const float p = __expf(s[kt][i] - mnew); s[kt][i] = p; ps += p; }
            lrun = lrun * alpha + ps;
#pragma unroll
            for (int db = 0; db < 4; ++db) o[db] *= alpha;
            bf16x8 pb[2];
#pragma unroll
            for (int kp = 0; kp < 2; ++kp) {
                u32x4 w; w.x = cvt_pk_bf16(s[2 * kp][0], s[2 * kp][1]); w.y = cvt_pk_bf16(s[2 * kp][2], s[2 * kp][3]);
                w.z = cvt_pk_bf16(s[2 * kp + 1][0], s[2 * kp + 1][1]); w.w = cvt_pk_bf16(s[2 * kp + 1][2], s[2 * kp + 1][3]);
                pb[kp] = __builtin_bit_cast(bf16x8, w);
            }
#pragma unroll
            for (int db = 0; db < 4; ++db)
#pragma unroll
                for (int kp = 0; kp < 2; ++kp) {
                    const LAS bf16_t* vp = Vt + (db * 16 + fr) * PKV_STRIDE + kp * 32 + 4 * fq;
                    const u32x2 v0 = *(const LAS u32x2*)vp, v1 = *(const LAS u32x2*)(vp + 16);
                    u32x4 w; w.x = v0.x; w.y = v0.y; w.z = v1.x; w.w = v1.y;
                    o[db] = __builtin_amdgcn_mfma_f32_16x16x32_bf16(__builtin_bit_cast(bf16x8, w), pb[kp], o[db], 0, 0, 0);
                }
        }
        if (ti < 8) { SA_COMMIT(bsel ^ 1); if (ti < 7) SA_ISSUE(ti + 2); }
        LDS_SYNC();
    }
#undef SA_ISSUE
#undef SA_COMMIT
    if (active) {
        lrun += __shfl_xor(lrun, 16); lrun += __shfl_xor(lrun, 32);
        const float inv = 1.0f / lrun;
        bf16_t* op = OC + (size_t)(qrow0 + fr) * D + h * 64 + 4 * fq;
#pragma unroll
        for (int db = 0; db < 4; ++db) { u32x2 w; w.x = cvt_pk_bf16(o[db][0] * inv, o[db][1] * inv); w.y = cvt_pk_bf16(o[db][2] * inv, o[db][3] * inv); *(u32x2*)(op + db * 16) = w; }
    }
}

__device__ __forceinline__ void poolconv_unit(const Args& a, int l, int ux) {
    int tid_ = threadIdx.x; asm volatile("" : "+v"(tid_));
    const int tid = tid_, c = tid & 255, half = tid >> 8;
    const float* PU = (const float*)(a.ws + WS_PU); const float* CIN = (const float*)(a.ws + WS_CIN); const float* CB = (const float*)(a.ws + WS_CB);
    bf16_t* OC = (bf16_t*)(a.ws + WS_OC);
    const int t0 = ux * 64 + half * 32; const bool sample = t0 >= TP;
    const int g = c >> 6, w = 2 << g;
    const float cw0 = a.in[17][(size_t)(l * 3 + 0) * 256 + c], cw1 = a.in[17][(size_t)(l * 3 + 1) * 256 + c], cw2 = a.in[17][(size_t)(l * 3 + 2) * 256 + c], cbias = a.in[18][l * 256 + c];
    const float* sp = a.in[4] + (size_t)l * NBATCH * 15 * 256; const float* sc = a.in[5] + (size_t)l * NBATCH * 2 * 256;
    float sum = 0.f, c1 = 0.f, c2 = 0.f;
    if (!sample) {
        for (int k = 1; k < w; ++k) if (t0 - k >= 0) sum += PU[(size_t)(t0 - k) * 256 + c];
        if (t0 >= 1) c1 = CIN[(size_t)(t0 - 1) * 256 + c];
        if (t0 >= 2) c2 = CIN[(size_t)(t0 - 2) * 256 + c];
    }
    for (int jb = 0; jb < 32; jb += 8) {
        float u8[8], ci8[8], cb8[8], od8[8];
#pragma unroll
        for (int q = 0; q < 8; ++q) {
            const int t = t0 + jb + q;
            u8[q] = PU[(size_t)t * 256 + c]; ci8[q] = CIN[(size_t)t * 256 + c]; cb8[q] = CB[(size_t)t * 256 + c];
            if (!sample) od8[q] = (t - w + 1 >= 0) ? PU[(size_t)(t - w + 1) * 256 + c] : 0.f;
            else { const int b = (t - TP) >> 4, e = ((t - TP) & 15) - w + 1; od8[q] = e >= 0 ? PU[(size_t)(t - w + 1) * 256 + c] : sp[(size_t)(b * 15 + 15 + e) * 256 + c]; }
        }
#pragma unroll
        for (int q = 0; q < 8; ++q) {
            const int t = t0 + jb + q; const float u = u8[q], ci = ci8[q];
            float cnt;
            if (!sample) {
                cnt = (float)((t + 1 < w) ? t + 1 : w);
                if (t >= TP - 15) a.out[O_PP + (size_t)l * 3840 + (size_t)(t - (TP - 15)) * 256 + c] = u;
                if (t >= TP - 2) a.out[O_CP + (size_t)l * 512 + (size_t)(t - (TP - 2)) * 256 + c] = ci;
            } else {
                const int b = (t - TP) >> 4, sq = (t - TP) & 15; cnt = (float)w;
                if (sq == 0) {
                    sum = 0.f; for (int k = 1; k < w; ++k) sum += sp[(size_t)(b * 15 + 15 - k) * 256 + c];
                    c1 = sc[(size_t)(b * 2 + 1) * 256 + c]; c2 = sc[(size_t)(b * 2) * 256 + c];
                }
                if (sq >= 1) a.out[O_PS + (size_t)l * 122880 + (size_t)(b * 15 + sq - 1) * 256 + c] = u;
                if (sq >= 14) a.out[O_CS + (size_t)l * 16384 + (size_t)(b * 2 + sq - 14) * 256 + c] = ci;
            }
            sum += u;
            const float dv = sum / cnt - u;
            sum -= od8[q];
            const float y = cbias + cw0 * c2 + cw1 * c1 + cw2 * ci;
            OC[(size_t)t * D + 512 + c] = (bf16_t)(cvt_pk_bf16(dv, 0.f) & 0xffffu);
            OC[(size_t)t * D + 768 + c] = (bf16_t)(cvt_pk_bf16(cb8[q] * y, 0.f) & 0xffffu);
            c2 = c1; c1 = ci;
        }
    }
}

constexpr int N_ATT_P = 1024, N_ATT_S = 256, N_PC = T / 64;
__device__ __forceinline__ void mixer_phase(const Args& a, LAS unsigned char* lds, int l, int bid, int gdim) {
    for (int u = bid; u < N_ATT_P + N_ATT_S + N_PC; u += gdim) {
        if (u < N_ATT_P) { if (MIXMASK & 1) attn_unit_p(a, lds, l, u); if (REPEAT & 128) attn_unit_p(a, lds, l, u); }
        else if (u < N_ATT_P + N_ATT_S) { if (MIXMASK & 2) attn_unit_s(a, lds, l, u - N_ATT_P); if (REPEAT & 256) attn_unit_s(a, lds, l, u - N_ATT_P); }
        else { if (MIXMASK & 4) poolconv_unit(a, l, u - N_ATT_P - N_ATT_S); if (REPEAT & 512) poolconv_unit(a, l, u - N_ATT_P - N_ATT_S); }
    }
    if (MIXMASK & 8) {
        const float* PU = (const float*)(a.ws + WS_PU); const float* CIN = (const float*)(a.ws + WS_CIN); bf16_t* OC = (bf16_t*)(a.ws + WS_OC);
        int tq = threadIdx.x; asm volatile("" : "+v"(tq));
        for (int i = bid * 512 + tq; i < T * 256; i += gdim * 512) { const size_t t = i >> 8, c = i & 255;
            const bf16_t* XBp = (const bf16_t*)(a.ws + WS_XB); bf16_t* MBp = (bf16_t*)(a.ws + WS_OC); MBp[t * D + c] = XBp[t * D + c]; MBp[t * D + 256 + c] = XBp[t * D + 256 + c]; MBp[t * D + 512 + c] = XBp[t * D + 512 + c]; MBp[t * D + 768 + c] = XBp[t * D + 768 + c]; }
    }
    LDS_SYNC();
}

#define XB_TMO      128
#define XB_XCNT(j)  (256  + 64 * (j))
#define XB_XSUB(j)  (1280 + 64 * (j))
#define XB_XGEN(j)  (2304 + 64 * (j))
#define XB_TOP      3328
#define XB_TOPGEN   3392
#define XCD_BAR_WORDS 3456
#define XB_SPIN_CAP (1u << 20)
__device__ __forceinline__ unsigned xb_ld(unsigned* p)              { return __hip_atomic_load(p, __ATOMIC_RELAXED, __HIP_MEMORY_SCOPE_AGENT); }
__device__ __forceinline__ unsigned xb_add(unsigned* p, unsigned v) { return __hip_atomic_fetch_add(p, v, __ATOMIC_RELAXED, __HIP_MEMORY_SCOPE_AGENT); }
__device__ __forceinline__ unsigned xb_xcc_id() { return (unsigned)__builtin_amdgcn_s_getreg((3 << 11) | 20) & 0xFu; }
#define XB_SPIN(cond, bar) do { unsigned _sp = 0; while (cond) { __builtin_amdgcn_s_sleep(1); \
    if ((++_sp & 255u) == 0u) { if (xb_ld(&(bar)[XB_TMO])) break; if (_sp > XB_SPIN_CAP) { atomicAdd(&(bar)[XB_TMO], 1u); break; } } } } while (0)
struct XcdBarrier { unsigned* bar; unsigned x; volatile LAS unsigned* st; };
__device__ __forceinline__ XcdBarrier xcd_barrier_post(unsigned* bar, volatile LAS unsigned* st) {
    XcdBarrier b; b.bar = bar; b.x = xb_xcc_id(); b.st = st;
    if (threadIdx.x == 0) (void)xb_add(&bar[XB_XCNT(b.x)], 1u);
    return b;
}
__device__ __forceinline__ void xcd_barrier_complete(unsigned* bar, unsigned x, unsigned& nloc, unsigned& nx) {
    const unsigned G = gridDim.x * gridDim.y * gridDim.z;
    unsigned sum, cnt, mine, sp = 0u;
    for (;;) {
        sum = 0u; cnt = 0u; mine = 0u;
#pragma unroll
        for (unsigned j = 0; j < 16; ++j) { const unsigned c = xb_ld(&bar[XB_XCNT(j)]); sum += c; cnt += (c > 0u) ? 1u : 0u; mine = (j == x) ? c : mine; }
        if (sum == G) break;
        __builtin_amdgcn_s_sleep(1);
        if ((++sp & 255u) == 0u) { if (xb_ld(&bar[XB_TMO])) break; if (sp > XB_SPIN_CAP) { atomicAdd(&bar[XB_TMO], 1u); break; } }
    }
    nloc = mine > 0u ? mine : 1u; nx = cnt > 0u ? cnt : 1u;
}
__device__ __forceinline__ void xcd_barrier(const XcdBarrier& b) {
    asm volatile("s_waitcnt vmcnt(0)" ::: "memory");
    __syncthreads();
    if (threadIdx.x == 0) {
        unsigned* bar = b.bar;
        __builtin_amdgcn_s_waitcnt(0);
        unsigned nloc = b.st[0], nx = b.st[1];
        if (nloc == 0u) { xcd_barrier_complete(bar, b.x, nloc, nx); b.st[0] = nloc; b.st[1] = nx; }
        const unsigned old = xb_add(&bar[XB_XSUB(b.x)], 1u);
        const unsigned gen = old / nloc;
        if (old + 1u == (gen + 1u) * nloc) {
            __builtin_amdgcn_fence(__ATOMIC_RELEASE, "agent");
            asm volatile("s_waitcnt vmcnt(0)" ::: "memory");
            const unsigned og = xb_add(&bar[XB_TOP], 1u);
            const unsigned tg = og / nx;
            if (og + 1u == (tg + 1u) * nx) xb_add(&bar[XB_TOPGEN], 1u);
            else XB_SPIN(xb_ld(&bar[XB_TOPGEN]) == tg, bar);
            __builtin_amdgcn_fence(__ATOMIC_ACQUIRE, "agent");
            xb_add(&bar[XB_XGEN(b.x)], 1u);
            asm volatile("s_waitcnt vmcnt(0)" ::: "memory");
        } else {
            XB_SPIN(xb_ld(&bar[XB_XGEN(b.x)]) == gen, bar);
            __builtin_amdgcn_fence(__ATOMIC_ACQUIRE, "agent");
            asm volatile("s_waitcnt vmcnt(0)" ::: "memory");
        }
    }
    __syncthreads();
}

constexpr int N_PHASES = 1 + 8 * DEPTH;
__global__ void __launch_bounds__(512, 2) fwd_kernel(Args a) {
    extern __shared__ __attribute__((aligned(16))) unsigned char lds_raw[];
    LAS unsigned char* lds = (LAS unsigned char*)lds_raw;
    unsigned char* ws = a.ws;
    float* ssq = (float*)(ws + WS_SSQ);
    bf16_t* XB = (bf16_t*)(ws + WS_XB); bf16_t* ACT = (bf16_t*)(ws + WS_ACT);
    volatile LAS unsigned* misc = (volatile LAS unsigned*)(lds + 131072 + 1024);
    if (threadIdx.x < 2) misc[threadIdx.x] = 0u;
    __syncthreads();
    const XcdBarrier xbar = xcd_barrier_post((unsigned*)ws, misc);
    for (int ph = a.ph_lo; ph < a.ph_hi; ++ph) {
        int bid = blockIdx.x, gdim = gridDim.x; asm volatile("" : "+s"(bid), "+s"(gdim));
        if (ph == 0) { if (PHMASK & 1) prologue(a, lds, bid, gdim); if (REPEAT & 1) { __syncthreads(); prologue(a, lds, bid, gdim); } asm volatile("s_waitcnt vmcnt(0) lgkmcnt(0)" ::: "memory"); __syncthreads(); }
        else {
            const int l = (ph - 1) >> 3, s = (ph - 1) & 7;
            const bf16_t* WL = (const bf16_t*)(ws + WS_W) + (size_t)l * LAYER_W_ELEMS;
            pg8::StaticOrder S;
            unsigned* const sready_base = (unsigned*)ws + 3840;
            if (DEFER_S && (s == 0 || s == 2 || s == 6) && ph > 1) {
                const int sp = s == 0 ? 7 : s - 1, lp = s == 0 ? l - 1 : l, KSp = sp == 5 ? 4 : 10;
                if (bid >= gdim - 8 * KSp) {
                    const bf16_t* WLp = (const bf16_t*)(ws + WS_W) + (size_t)lp * LAYER_W_ELEMS;
                    pg8::Gemm g2{sp == 5 ? (const bf16_t*)(ws + WS_MB) : ACT, WLp + (sp == 1 ? W_1OUT : (sp == 5 ? W_O : W_2OUT)), sp == 5 ? D : FF};
                    pg8::SliceOrder SL; SL.init(gdim, bid, KSp);
                    pg8::EpiResid E2{nullptr, XB, ssq + (size_t)(3 * lp + (sp == 1 ? 1 : (sp == 5 ? 2 : 3))) * T * 16, sp == 5 ? 1.0f : 0.5f,
                                     pg8::SplitK{(float*)(ws + WS_SLAB), (unsigned*)ws + 3584 + lp * 64 + sp * 8, KSp}};
                    pg8::gemm_phase(lds, g2, SL, E2);
                    asm volatile("s_waitcnt vmcnt(0)" ::: "memory");
                    __syncthreads();
                    if (threadIdx.x == 0) { __builtin_amdgcn_fence(__ATOMIC_RELEASE, "agent"); asm volatile("s_waitcnt vmcnt(0)" ::: "memory");
                        (void)__hip_atomic_fetch_add(sready_base + lp * 4 + (sp == 1 ? 0 : (sp == 5 ? 1 : 2)), 1u, __ATOMIC_RELAXED, __HIP_MEMORY_SCOPE_AGENT); }
                }
                S.sready = sready_base + lp * 4 + (sp == 1 ? 0 : (sp == 5 ? 1 : 2)); S.expect = 8u * (unsigned)KSp;
            }
            if (s == 0 || s == 6) {
                pg8::Gemm g{XB, WL + (s == 0 ? W_1IN : W_2IN), D}; S.init(T, NIN, gdim, bid);
                pg8::EpiSwiglu E{ssq + (size_t)(3 * l + (s == 0 ? 0 : 2)) * T * 16, ACT};
                if (PHMASK & 2) pg8::gemm_phase(lds, g, S, E);
                if (REPEAT & 2) pg8::gemm_phase(lds, g, S, E);
            } else if (s == 1 || s == 5 || s == 7) {
                pg8::Gemm g{s == 5 ? (const bf16_t*)(ws + WS_MB) : ACT, WL + (s == 1 ? W_1OUT : (s == 5 ? W_O : W_2OUT)), s == 5 ? D : FF}; pg8::SplitOrder SO; SO.init(D, gdim, bid, s == 5 ? 4 : 11);
                pg8::EpiResid E{ph == N_PHASES - 1 ? a.out : nullptr, XB, ssq + (size_t)(3 * l + (s == 1 ? 1 : (s == 5 ? 2 : 3))) * T * 16, s == 5 ? 1.0f : 0.5f,
                                 pg8::SplitK{(float*)(ws + WS_SLAB), (unsigned*)ws + 3584 + ((ph - 1) >> 3) * 64 + s * 8, s == 5 ? 4 : 11}};
                if (DEFER_S && ph != N_PHASES - 1) { pg8::POrder PO; PO.init(D, gdim, bid); pg8::gemm_phase(lds, g, PO, E); }
                else pg8::gemm_phase(lds, g, SO, E);
            } else if (s == 2) {
                pg8::Gemm g{XB, WL + W_MIX, D}; S.init(T, NIN, gdim, bid);
                pg8::EpiMix E{ssq + (size_t)(3 * l + 1) * T * 16, a.in[12] + l * 64, a.in[13] + l * 64, a.in[11] + l * 3072,
                              (bf16_t*)(ws + WS_Q), (bf16_t*)(ws + WS_K), (bf16_t*)(ws + WS_V), (bf16_t*)(ws + WS_G), (float*)(ws + WS_PU), (float*)(ws + WS_CIN), (float*)(ws + WS_CB),
                              a.out + O_KP + (size_t)l * 262144, a.out + O_VP + (size_t)l * 262144, a.out + O_KS + (size_t)l * 262144, a.out + O_VS + (size_t)l * 262144, a.out, (bf16_t*)(ws + WS_VT)};
                if (PHMASK & 8) pg8::gemm_phase(lds, g, S, E);
                if (REPEAT & 8) pg8::gemm_phase(lds, g, S, E);
            } else if (s == 3) {
                if (PHMASK & 16) mixer_phase(a, lds, l, bid, gdim);
                if (REPEAT & 16) mixer_phase(a, lds, l, bid, gdim);
            } else {
                pg8::Gemm g{(const bf16_t*)(ws + WS_OC), WL + W_BR, D}; pg8::SplitOrder SO; SO.init(D, gdim, bid, 4);
                pg8::EpiBranch E{(const bf16_t*)(ws + WS_G), (bf16_t*)(ws + WS_MB), a.out, pg8::SplitK{(float*)(ws + WS_SLAB), (unsigned*)ws + 3584 + ((ph - 1) >> 3) * 64 + s * 8, 4}};
                if (PHMASK & 32) pg8::gemm_phase(lds, g, SO, E);
            }
        }
        if (ph + 1 < a.ph_hi) { if (ph == a.ph_lo) cg::this_grid().sync(); else xcd_barrier(xbar); if (REPEAT & 64) xcd_barrier(xbar); }
    }
}

extern "C" void kernel_launch(void* const* d_in, const int* in_sizes, int n_in, void* d_out, int out_size, void* d_ws, size_t ws_size, hipStream_t stream) {
    static int grid = 0;
    if (grid == 0) {
        if (n_in != 26 || out_size != (int)O_END || ws_size < WS_END) { fprintf(stderr, "kernel_launch: unexpected shapes: n_in %d out %d ws %zu\n", n_in, out_size, ws_size); grid = -1; return; }
        int dev = 0, cus = 0, per_cu = 0;
        hipGetDevice(&dev); hipDeviceGetAttribute(&cus, hipDeviceAttributeMultiprocessorCount, dev);
        if (hipFuncSetAttribute((const void*)fwd_kernel, hipFuncAttributeMaxDynamicSharedMemorySize, LDS_BYTES) != hipSuccess) { fprintf(stderr, "kernel_launch: hipFuncSetAttribute failed\n"); grid = -1; return; }
        hipOccupancyMaxActiveBlocksPerMultiprocessor(&per_cu, (const void*)fwd_kernel, 512, LDS_BYTES);
        (void)hipGetLastError();
        if (per_cu < 1) per_cu = 1;
        grid = cus;
        if (cus != 256) { fprintf(stderr, "kernel_launch: built for 256 CUs (one prompt tile per CU in the N = 1024 GEMMs), got %d\n", cus); grid = -1; return; }
        fprintf(stderr, "kernel_launch: cus %d per_cu %d grid %d\n", cus, per_cu, grid);
    }
    if (grid < 0) return;
    Args a{};
    for (int i = 0; i < 26; ++i) a.in[i] = (const float*)d_in[i];
    a.out = (float*)d_out; a.ws = (unsigned char*)d_ws;
    if (hipMemsetAsync(d_ws, 0, 16384, stream) != hipSuccess) { fprintf(stderr, "kernel_launch: memset of the barrier words failed\n"); return; }
#if MK_ONE_LAUNCH
    a.ph_lo = 0; a.ph_hi = N_PHASES;
    void* args[] = {&a};
    hipError_t e = hipLaunchCooperativeKernel((const void*)fwd_kernel, dim3(grid), dim3(512), args, LDS_BYTES, stream);
    if (e != hipSuccess) fprintf(stderr, "cooperative launch failed: %s (grid %d)\n", hipGetErrorString(e), grid);
#else
    for (int ph = 0; ph < N_PHASES; ++ph) {
        a.ph_lo = ph; a.ph_hi = ph + 1;
        hipLaunchKernelGGL(fwd_kernel, dim3(grid), dim3(512), LDS_BYTES, stream, a);
    }
#endif
}
```
